# Optimizing an MI355X kernel written in HIP

```python
import math
import jax, jax.numpy as jnp
from jax import lax
import numpy as np

D_MODEL = 1024
BATCH = 8
SEQ = 4096
DEPTH = 1

PLE_DIM = 256
D_FF = 2816
FFN_RES_WEIGHT = 0.5
NORM_EPS = 1e-6
Q_BLOCK = 128

MLA_HEADS = 8
MLA_NOPE = 64
MLA_ROPE = 32
MLA_QK = MLA_NOPE + MLA_ROPE
MLA_V = 64
Q_LORA = 384
KV_LORA = 256
ROPE_BASE = 10000.0

SB_HEADS = 8
SB_HEAD_DIM = 64
SB_WIDTH = SB_HEADS * SB_HEAD_DIM
MLA_WIDTH = MLA_HEADS * MLA_V

COL_CQ = Q_LORA
COL_CKV = KV_LORA
COL_KROPE = MLA_ROPE
COL_SB = 3 * SB_WIDTH
COL_GATES = 2 * D_MODEL
IN_COLS = COL_CQ + COL_CKV + COL_KROPE + COL_SB + COL_GATES
SPLITS = list(np.cumsum([COL_CQ, COL_CKV, COL_KROPE, COL_SB])[:])

kernel_name = "hybrid_mla_stickbreaking_macaron_ple"


def rms_norm(x, g):
    xf = x.astype(jnp.float32)
    r = lax.rsqrt(jnp.mean(xf * xf, axis=-1, keepdims=True) + NORM_EPS)
    return (xf * r).astype(x.dtype) * g


def apply_rope(x, positions):
    r = x.shape[-1]
    inv_freq = ROPE_BASE ** (-jnp.arange(0, r, 2, dtype=jnp.float32) / r)
    ang = positions.astype(jnp.float32)[..., None] * inv_freq
    cos = jnp.cos(ang)[:, :, None, :].astype(x.dtype)
    sin = jnp.sin(ang)[:, :, None, :].astype(x.dtype)
    x1, x2 = x[..., : r // 2], x[..., r // 2:]
    return jnp.concatenate([x1 * cos - x2 * sin, x2 * cos + x1 * sin], axis=-1)


def swiglu(u, w_in, w_out):
    a, b = jnp.split(u @ w_in, 2, axis=-1)
    return (jax.nn.silu(a) * b) @ w_out


def causal_softmax_attention(q, k, v):
    s_len = q.shape[2]
    scale = 1.0 / math.sqrt(q.shape[-1])
    outs = []
    for i in range(s_len // Q_BLOCK):
        k_len = (i + 1) * Q_BLOCK
        qb = q[:, :, i * Q_BLOCK:(i + 1) * Q_BLOCK]
        kb, vb = k[:, :, :k_len], v[:, :, :k_len]
        sc = jnp.einsum('bhqd,bhkd->bhqk', qb, kb).astype(jnp.float32) * scale
        q_pos = i * Q_BLOCK + jnp.arange(Q_BLOCK)
        mask = jnp.arange(k_len)[None, :] <= q_pos[:, None]
        w = jax.nn.softmax(jnp.where(mask, sc, -jnp.inf), axis=-1)
        outs.append(jnp.einsum('bhqk,bhkd->bhqd', w.astype(vb.dtype), vb))
    return jnp.concatenate(outs, axis=2)


def stick_breaking_attention(q, k, v):
    s_len = q.shape[2]
    scale = 1.0 / math.sqrt(q.shape[-1])
    outs = []
    for i in range(s_len // Q_BLOCK):
        k_len = (i + 1) * Q_BLOCK
        qb = q[:, :, i * Q_BLOCK:(i + 1) * Q_BLOCK]
        kb, vb = k[:, :, :k_len], v[:, :, :k_len]
        z = jnp.einsum('bhqd,bhkd->bhqk', qb, kb).astype(jnp.float32) * scale
        q_pos = i * Q_BLOCK + jnp.arange(Q_BLOCK)
        mask = jnp.arange(k_len)[None, :] < q_pos[:, None]
        log_1m = jnp.where(mask, jax.nn.log_sigmoid(-z), 0.0)
        suffix = lax.cumsum(log_1m, axis=3, reverse=True) - log_1m
        a = jnp.where(mask, jnp.exp(jax.nn.log_sigmoid(z) + suffix), 0.0)
        outs.append(jnp.einsum('bhqk,bhkd->bhqd', a.astype(vb.dtype), vb))
    return jnp.concatenate(outs, axis=2)


def setup_inputs(seed: int = 0) -> dict:
    key = jax.random.key(seed)
    ks = iter(jax.random.split(key, 32))
    f32 = jnp.float32

    def w(shape, fan_in):
        return jax.random.normal(next(ks), (DEPTH,) + shape, f32) * fan_in ** -0.5

    def gain(n):
        return 1.0 + 0.02 * jax.random.normal(next(ks), (DEPTH, n), f32)

    x = jax.random.normal(next(ks), (BATCH, SEQ, D_MODEL), f32)
    p = jax.random.normal(next(ks), (DEPTH, BATCH, SEQ, PLE_DIM), f32)
    offset = jax.random.randint(next(ks), (BATCH, 1), 0, 1024, dtype=jnp.int32)
    positions = offset + jnp.arange(SEQ, dtype=jnp.int32)[None, :]
    return {
        "x": x,
        "p": p,
        "positions": positions,
        "ffn1_norm": gain(D_MODEL),
        "ffn1_w_in": w((D_MODEL, 2 * D_FF), D_MODEL),
        "ffn1_w_out": w((D_FF, D_MODEL), D_FF),
        "mix_norm": gain(D_MODEL),
        "w_in": w((D_MODEL, IN_COLS), D_MODEL),
        "q_latent_norm": gain(Q_LORA),
        "w_q_up": w((Q_LORA, MLA_HEADS * MLA_QK), Q_LORA),
        "kv_latent_norm": gain(KV_LORA),
        "w_kv_up": w((KV_LORA, MLA_HEADS * (MLA_NOPE + MLA_V)), KV_LORA),
        "q_head_norm": gain(MLA_QK),
        "k_head_norm": gain(MLA_QK),
        "w_branch_mla": w((MLA_WIDTH, D_MODEL), MLA_WIDTH),
        "w_branch_sb": w((SB_WIDTH, D_MODEL), SB_WIDTH),
        "w_out": w((D_MODEL, D_MODEL), D_MODEL),
        "ffn2_norm": gain(D_MODEL),
        "ffn2_w_in": w((D_MODEL, 2 * D_FF), D_MODEL),
        "ffn2_w_out": w((D_FF, D_MODEL), D_FF),
        "ple_norm": gain(D_MODEL),
        "w_ple_gate": w((D_MODEL, D_MODEL), D_MODEL),
        "w_ple_proj": w((PLE_DIM, D_MODEL), PLE_DIM),
    }


def reference(x, p, positions, ffn1_norm, ffn1_w_in, ffn1_w_out, mix_norm, w_in,
              q_latent_norm, w_q_up, kv_latent_norm, w_kv_up, q_head_norm, k_head_norm,
              w_branch_mla, w_branch_sb, w_out, ffn2_norm, ffn2_w_in, ffn2_w_out,
              ple_norm, w_ple_gate, w_ple_proj):
    b, s, _ = x.shape
    h = x
    for i in range(DEPTH):
        h = h + FFN_RES_WEIGHT * swiglu(rms_norm(h, ffn1_norm[i]), ffn1_w_in[i], ffn1_w_out[i])

        u = rms_norm(h, mix_norm[i])
        proj = u @ w_in[i]
        c_q, c_kv, k_rope, sb_qkv, gates = jnp.split(proj, SPLITS, axis=-1)

        q = (rms_norm(c_q, q_latent_norm[i]) @ w_q_up[i]).reshape(b, s, MLA_HEADS, MLA_QK)
        kv = (rms_norm(c_kv, kv_latent_norm[i]) @ w_kv_up[i]).reshape(b, s, MLA_HEADS, MLA_NOPE + MLA_V)
        k_nope, v_mla = kv[..., :MLA_NOPE], kv[..., MLA_NOPE:]
        k_r = jnp.broadcast_to(k_rope[:, :, None, :], (b, s, MLA_HEADS, MLA_ROPE))
        k = jnp.concatenate([k_nope, k_r], axis=-1)
        q = rms_norm(q, q_head_norm[i])
        k = rms_norm(k, k_head_norm[i])
        q = jnp.concatenate([q[..., :MLA_NOPE], apply_rope(q[..., MLA_NOPE:], positions)], axis=-1)
        k = jnp.concatenate([k[..., :MLA_NOPE], apply_rope(k[..., MLA_NOPE:], positions)], axis=-1)
        o_mla = causal_softmax_attention(q.transpose(0, 2, 1, 3), k.transpose(0, 2, 1, 3),
                                         v_mla.transpose(0, 2, 1, 3))
        o_mla = o_mla.transpose(0, 2, 1, 3).reshape(b, s, MLA_WIDTH)

        sq, sk, sv = [t.reshape(b, s, SB_HEADS, SB_HEAD_DIM).transpose(0, 2, 1, 3)
                      for t in jnp.split(sb_qkv, 3, axis=-1)]
        o_sb = stick_breaking_attention(sq, sk, sv)
        o_sb = o_sb.transpose(0, 2, 1, 3).reshape(b, s, SB_WIDTH)

        g_mla, g_sb = jnp.split(jax.nn.sigmoid(gates), 2, axis=-1)
        merged = g_mla * (o_mla @ w_branch_mla[i]) + g_sb * (o_sb @ w_branch_sb[i])
        h = h + merged @ w_out[i]

        h = h + FFN_RES_WEIGHT * swiglu(rms_norm(h, ffn2_norm[i]), ffn2_w_in[i], ffn2_w_out[i])

        ple_gate = jax.nn.sigmoid(rms_norm(h, ple_norm[i]) @ w_ple_gate[i])
        h = h + ple_gate * (p[i] @ w_ple_proj[i])
    return h
```

```cpp
#include <hip/hip_runtime.h>
#include <hip/hip_cooperative_groups.h>
#include <cstdio>
#include <cstdint>
namespace cg = cooperative_groups;
namespace pg8 {
#define PG8_LAS __attribute__((address_space(3)))
typedef unsigned short bf16_t;
typedef short bf16x8 __attribute__((ext_vector_type(8)));
typedef float f32x4 __attribute__((ext_vector_type(4)));
typedef unsigned u32x4 __attribute__((ext_vector_type(4)));
constexpr int BM = 256, BK = 64, HALF = 128, HTB = HALF * BK * 2  , STAGE_BYTES = 8 * HTB, NXCD = 8, WGM = 8;

__host__ __device__ __forceinline__ int lds_byte(int r, int c) { const int st = (r >> 4) * 2 + (c >> 5), rr = r & 15, cc = c & 31, ob = rr * 64 + cc * 2; return st * 1024 + (ob ^ (((ob >> 9) & 1) << 5)); }
__host__ __device__ __forceinline__ void stage_rc(int b, int& R, int& C) { const int st = b / 1024, sb = b % 1024, swz = sb ^ (((sb >> 9) & 1) << 5); R = (st >> 1) * 16 + swz / 64; C = (st & 1) * 32 + (swz % 64) / 2; }
__host__ __device__ __forceinline__ int perm32(int rho) { const int n = rho >> 4, i = rho & 15; return 8 * (i >> 2) + 4 * n + (i & 3); }

struct Unit { int pm, pn; };
struct Gemm { const bf16_t* A; const bf16_t* Bt; int M, N, K; };

struct StaticOrder {
    int nM, nN, nwg, G, c;
    __host__ __device__ void init(int M, int N, int G_, int c_) { nM = M / BM; nN = N / BM; nwg = nM * nN; G = G_; c = c_; }
    __host__ __device__ bool next(int i, Unit& u) const {
        const long L = (long)i * G + c; if (L >= nwg) return false;
        int wgid = (int)L; { const int q = nwg / NXCD, r = nwg % NXCD, xcd = wgid % NXCD, off = wgid / NXCD; wgid = (xcd < r ? xcd * (q + 1) : r * (q + 1) + (xcd - r) * q) + off; }
        const int nig = WGM * nN, gid = wgid / nig, fm = gid * WGM, gsz = (nM - fm) < WGM ? (nM - fm) : WGM;
        u.pm = fm + ((wgid % nig) % gsz); u.pn = (wgid % nig) / gsz; return true;
    }
    __device__ __forceinline__ void a_ready(const Unit&) const {}
    __device__ __forceinline__ void done(const Unit&) const {}
};

__device__ __forceinline__ unsigned cvt_pk_bf16(float lo, float hi) { unsigned r; asm volatile("v_cvt_pk_bf16_f32 %0, %1, %2" : "=v"(r) : "v"(lo), "v"(hi)); return r; }
typedef float f32x2 __attribute__((ext_vector_type(2)));
template <class Epi, class Sched, bool ALIGN_EPI = false, bool SP2 = false>
__device__ __forceinline__ void gemm_phase(PG8_LAS unsigned char* lds, const Gemm g, const Sched& S, const Epi& E) {
    int tid_ = threadIdx.x; asm volatile("" : "+v"(tid_)); const int tid = tid_, wid = __builtin_amdgcn_readfirstlane(tid >> 6), lane = tid & 63, wr = wid >> 2, wc = wid & 3, fr = lane & 15, fq = lane >> 4;
    const int K = g.K, nt = K / BK;
    unsigned voffA[2], voffB[2];
#pragma unroll
    for (int i = 0; i < 2; ++i) { int R, C; stage_rc(tid * 16 + i * 8192, R, C); const int Rb = Epi::PERM ? ((R & ~31) + perm32(R & 31)) : R;
        voffA[i] = (unsigned)(R * K + C) * 2u; voffB[i] = (unsigned)(Rb * K + C) * 2u; }
    const size_t kstep = (size_t)(BK * 2);
    const size_t hstep = (size_t)HALF * K * 2;
    const size_t tstep = 2 * hstep;
    const unsigned ldsw = (unsigned)wid * 1024u;
    const int aoff = lds_byte(wr * 64 + fr, fq * 8), boff = lds_byte(wc * 32 + fr, fq * 8);
#define PG8_SA(b, h) (((b) * 2 + (h)) * HTB)
#define PG8_SB(b, h) ((4 + (b) * 2 + (h)) * HTB)
#define PG8_STAGE(bufoff, gbase, voff) do { _Pragma("unroll") for (int _i = 0; _i < 2; ++_i) \
        __builtin_amdgcn_global_load_lds((const unsigned*)((const char*)(gbase) + (voff)[_i]), (PG8_LAS unsigned*)(lds + (bufoff) + ldsw + _i * 8192), 16, 0, 0); } while (0)
#define PG8_LDA(dst, b, h) do { _Pragma("unroll") for (int m = 0; m < 4; ++m) _Pragma("unroll") for (int k = 0; k < 2; ++k) dst[m][k] = *(const PG8_LAS bf16x8*)(lds + PG8_SA(b, h) + aoff + m * 2048 + k * 1024); } while (0)
#define PG8_LDB(dst, b, h) do { _Pragma("unroll") for (int n = 0; n < 2; ++n) _Pragma("unroll") for (int k = 0; k < 2; ++k) dst[n][k] = *(const PG8_LAS bf16x8*)(lds + PG8_SB(b, h) + boff + n * 2048 + k * 1024); } while (0)
#define PG8_MMA(ai, bj, At, Bt) do { __builtin_amdgcn_s_setprio(1); _Pragma("unroll") for (int m = 0; m < 4; ++m) _Pragma("unroll") for (int n = 0; n < 2; ++n) _Pragma("unroll") for (int k = 0; k < 2; ++k) \
        acc[ai][bj][m][n] = __builtin_amdgcn_mfma_f32_16x16x32_bf16(Bt[n][k], At[m][k], acc[ai][bj][m][n], 0, 0, 0); __builtin_amdgcn_s_setprio(0); } while (0)
#define PG8_WAIT_V(n) asm volatile("s_waitcnt vmcnt(" #n ")" ::: "memory")
#define PG8_WAIT_L(n) asm volatile("s_waitcnt lgkmcnt(" #n ")" ::: "memory")
#define PG8_BAR __builtin_amdgcn_s_barrier()
#define PG8_SCHED __builtin_amdgcn_sched_barrier(0)
    Unit cur, nxt; int ui = 0;
    if (!S.next(0, cur)) return;
    f32x4 acc[2][2][4][2];
#pragma unroll
    for (int a = 0; a < 2; ++a)
#pragma unroll
        for (int b = 0; b < 2; ++b)
#pragma unroll
            for (int m = 0; m < 4; ++m)
#pragma unroll
                for (int n = 0; n < 2; ++n) acc[a][b][m][n] = (f32x4){0.f, 0.f, 0.f, 0.f};
    bf16x8 At[4][2], B0[2][2], B1[2][2];
    const char* cA = (const char*)g.A + (size_t)cur.pm * tstep; const char* cB = (const char*)g.Bt + (size_t)cur.pn * tstep;
    S.a_ready(cur);
    if constexpr (SP2) {
        PG8_STAGE(PG8_SB(0, 0), cB, voffB); PG8_STAGE(PG8_SB(0, 1), cB + hstep, voffB); PG8_STAGE(PG8_SA(0, 0), cA, voffA); PG8_STAGE(PG8_SA(0, 1), cA + hstep, voffA);
        if (wr == 1) PG8_BAR;
        PG8_WAIT_V(2); PG8_BAR;
        PG8_STAGE(PG8_SB(1, 0), cB + kstep, voffB); PG8_STAGE(PG8_SA(1, 0), cA + kstep, voffA); PG8_STAGE(PG8_SB(1, 1), cB + hstep + kstep, voffB);
        PG8_WAIT_V(6); PG8_BAR;
    } else {
        PG8_STAGE(PG8_SB(0, 0), cB, voffB); PG8_STAGE(PG8_SA(0, 0), cA, voffA); PG8_STAGE(PG8_SB(0, 1), cB + hstep, voffB); PG8_STAGE(PG8_SA(0, 1), cA + hstep, voffA);
        if (wr == 1) PG8_BAR;
        PG8_WAIT_V(4); PG8_BAR;
        PG8_STAGE(PG8_SB(1, 0), cB + kstep, voffB); PG8_STAGE(PG8_SA(1, 0), cA + kstep, voffA); PG8_STAGE(PG8_SB(1, 1), cB + hstep + kstep, voffB);
        PG8_WAIT_V(6); PG8_BAR;
    }
    for (;;) {
        const bool has_next = S.next(ui + 1, nxt);
        const char* nA = has_next ? (const char*)g.A + (size_t)nxt.pm * tstep : cA; const char* nB = has_next ? (const char*)g.Bt + (size_t)nxt.pn * tstep : cB;
        for (int t = 0; t < nt; t += 2) {
            const bool last = (t == nt - 2);
            const char* a1 = cA + (size_t)(t + 1) * kstep;
            const char* a2 = last ? nA : cA + (size_t)(t + 2) * kstep; const char* b2 = last ? nB : cB + (size_t)(t + 2) * kstep;
            const char* a3 = a2 + kstep; const char* b3 = b2 + kstep;
            if (last && has_next) S.a_ready(nxt);
            if constexpr (SP2) {
            PG8_LDB(B0, 0, 0); PG8_LDB(B1, 0, 1); PG8_SCHED; PG8_LDA(At, 0, 0); PG8_STAGE(PG8_SA(1, 1), a1 + hstep, voffA);
            PG8_WAIT_V(8); PG8_WAIT_L(0); PG8_BAR; PG8_MMA(0, 0, At, B0); PG8_MMA(0, 1, At, B1); PG8_BAR; PG8_SCHED;
            PG8_LDA(At, 0, 1); PG8_STAGE(PG8_SB(0, 0), b2, voffB); PG8_STAGE(PG8_SB(0, 1), b2 + hstep, voffB); PG8_STAGE(PG8_SA(0, 0), a2, voffA);
            PG8_WAIT_V(8); PG8_WAIT_L(0); PG8_BAR; PG8_MMA(1, 0, At, B0); PG8_MMA(1, 1, At, B1); PG8_BAR; PG8_SCHED;
            PG8_LDB(B0, 1, 0); PG8_LDB(B1, 1, 1); PG8_SCHED; PG8_LDA(At, 1, 0); PG8_STAGE(PG8_SA(0, 1), a2 + hstep, voffA);
            PG8_WAIT_V(8); PG8_WAIT_L(0); PG8_BAR; PG8_MMA(0, 0, At, B0); PG8_MMA(0, 1, At, B1); PG8_BAR; PG8_SCHED;
            PG8_LDA(At, 1, 1); PG8_STAGE(PG8_SB(1, 0), b3, voffB); PG8_STAGE(PG8_SB(1, 1), b3 + hstep, voffB); PG8_STAGE(PG8_SA(1, 0), a3, voffA);
            PG8_WAIT_V(8); PG8_WAIT_L(0); PG8_BAR; PG8_MMA(1, 0, At, B0); PG8_MMA(1, 1, At, B1); PG8_BAR; PG8_SCHED;
            } else {
            PG8_LDB(B0, 0, 0); PG8_SCHED; PG8_LDA(At, 0, 0); PG8_STAGE(PG8_SA(1, 1), a1 + hstep, voffA);
            PG8_WAIT_L(8); PG8_BAR; PG8_WAIT_L(0); PG8_MMA(0, 0, At, B0); PG8_BAR; PG8_SCHED;
            PG8_LDB(B1, 0, 1); PG8_STAGE(PG8_SB(0, 0), b2, voffB);
            PG8_BAR; PG8_WAIT_L(0); PG8_MMA(0, 1, At, B1); PG8_BAR;
            PG8_LDA(At, 0, 1); PG8_STAGE(PG8_SA(0, 0), a2, voffA);
            PG8_BAR; PG8_WAIT_L(0); PG8_MMA(1, 0, At, B0); PG8_BAR; PG8_SCHED;
            PG8_STAGE(PG8_SB(0, 1), b2 + hstep, voffB);
            PG8_WAIT_V(6); PG8_BAR; PG8_MMA(1, 1, At, B1); PG8_BAR;
            PG8_LDB(B0, 1, 0); PG8_SCHED; PG8_LDA(At, 1, 0); PG8_STAGE(PG8_SA(0, 1), a2 + hstep, voffA);
            PG8_WAIT_L(8); PG8_BAR; PG8_WAIT_L(0); PG8_MMA(0, 0, At, B0); PG8_BAR; PG8_SCHED;
            PG8_LDB(B1, 1, 1); PG8_STAGE(PG8_SB(1, 0), b3, voffB);
            PG8_BAR; PG8_WAIT_L(0); PG8_MMA(0, 1, At, B1); PG8_BAR;
            PG8_LDA(At, 1, 1); PG8_STAGE(PG8_SA(1, 0), a3, voffA);
            PG8_BAR; PG8_WAIT_L(0); PG8_MMA(1, 0, At, B0); PG8_BAR; PG8_SCHED;
            PG8_STAGE(PG8_SB(1, 1), b3 + hstep, voffB);
            PG8_WAIT_V(6); PG8_BAR; PG8_MMA(1, 1, At, B1); PG8_BAR;
            }
        }
        if constexpr (ALIGN_EPI) { if (wr == 0) PG8_BAR; }
        if constexpr (!Epi::AFTER_DRAIN) { E(acc, cur, wr, wc, fr, fq); S.done(cur); }
        if (!has_next) break;
#pragma unroll
        for (int a = 0; a < 2; ++a)
#pragma unroll
            for (int b = 0; b < 2; ++b)
#pragma unroll
                for (int m = 0; m < 4; ++m)
#pragma unroll
                    for (int n = 0; n < 2; ++n) acc[a][b][m][n] = (f32x4){0.f, 0.f, 0.f, 0.f};
        cur = nxt; cA = nA; cB = nB; ++ui;
        if constexpr (ALIGN_EPI) { if (wr == 1) PG8_BAR; }
    }
    PG8_WAIT_V(0);
    if constexpr (!ALIGN_EPI) { if (wr == 0) PG8_BAR; }
    PG8_BAR;
    if constexpr (Epi::AFTER_DRAIN) { E.fused(acc, cur, wr, wc, fr, fq, lds, wid, lane); S.done(cur); }
#undef PG8_SA
#undef PG8_SB
#undef PG8_STAGE
#undef PG8_LDA
#undef PG8_LDB
#undef PG8_MMA
#undef PG8_WAIT_V
#undef PG8_WAIT_L
#undef PG8_BAR
#undef PG8_SCHED
}
}
#ifndef PG8_SP2
#define PG8_SP2 true
#endif
#ifndef PG8_ALIGN
#define PG8_ALIGN true
#endif

#define LAS __attribute__((address_space(3)))
typedef unsigned char uchar;
typedef unsigned short bf16;
typedef unsigned u32x4 __attribute__((ext_vector_type(4)));
typedef unsigned u32x2 __attribute__((ext_vector_type(2)));
typedef float f32x4 __attribute__((ext_vector_type(4)));
typedef float f32x2 __attribute__((ext_vector_type(2)));
typedef float f32x16 __attribute__((ext_vector_type(16)));
typedef short bf16x8 __attribute__((ext_vector_type(8)));
typedef short s16x4 __attribute__((ext_vector_type(4)));
typedef __bf16 bf16x2_t __attribute__((ext_vector_type(2)));
#define DI __device__ __forceinline__
#define MFMA32(a, b, c) __builtin_amdgcn_mfma_f32_32x32x16_bf16((a), (b), (c), 0, 0, 0)

DI unsigned pk2(float a, float b) { f32x2 v = {a, b}; return __builtin_bit_cast(unsigned, __builtin_convertvector(v, bf16x2_t)); }
DI float bf_lo(unsigned u) { return __uint_as_float(u << 16); }
DI float bf_hi(unsigned u) { return __uint_as_float(u & 0xffff0000u); }
DI u32x4 pack8(f32x4 a, f32x4 b) { u32x4 w; w.x = pk2(a[0], a[1]); w.y = pk2(a[2], a[3]); w.z = pk2(b[0], b[1]); w.w = pk2(b[2], b[3]); return w; }
DI float sigmoidf_(float v) { return __builtin_amdgcn_rcpf(1.0f + __builtin_amdgcn_exp2f(-1.44269504089f * v)); }
DI float wave_sum(float v) {
#pragma unroll
    for (int o = 1; o < 64; o <<= 1) v += __shfl_xor(v, o);
    return v;
}

constexpr int T = 32768, DM = 1024, FF = 2816, SEQ = 4096;
constexpr float NORM_EPS = 1e-6f;
constexpr float LOG2E = 1.44269504089f;
constexpr float QSCALE_MLA = 0.10206207261596577f * 1.44269504089f;
constexpr float QSCALE_SB = 0.125f * 1.44269504089f;
constexpr size_t MiB = 1u << 20;
constexpr size_t WS_FF1IN = 1 * MiB, WS_FF1OUT = 12 * MiB, WS_FF2IN = 18 * MiB, WS_FF2OUT = 29 * MiB, WS_WIN = 35 * MiB, WS_WSBV = 43 * MiB,
                 WS_WQ = 44 * MiB, WS_WKN = 45 * MiB, WS_WV = 45 * MiB + 512 * 1024, WS_WBM = 46 * MiB, WS_WBS = 47 * MiB, WS_WOUT = 48 * MiB,
                 WS_WG = 50 * MiB, WS_WP = 52 * MiB;
constexpr size_t WS_XN = 54 * MiB, WS_H = 118 * MiB, WS_BIG = 246 * MiB;
constexpr size_t WS_KM = WS_XN, WS_MERGED = WS_XN;
constexpr size_t WS_ACT = WS_BIG, WS_CQ = WS_BIG, WS_CKV = WS_BIG + 24 * MiB, WS_OM = WS_BIG, WS_SBQ = WS_BIG + 40 * MiB, WS_SBK = WS_BIG + 72 * MiB,
                 WS_VTS = WS_BIG + 104 * MiB, WS_QM = WS_BIG + 136 * MiB, WS_VTM = WS_BIG + 184 * MiB, WS_KR = WS_BIG + 216 * MiB,
                 WS_TMP = WS_BIG + 72 * MiB, WS_PB = WS_BIG + 200 * MiB, WS_END = WS_BIG + 220 * MiB;
constexpr int LDS_BYTES = 147456;

struct Params { const float* in[23]; float* out; unsigned char* ws; };

struct Job { int src, K, Nsrc, Ndst, mode, off; unsigned long long dst; };
constexpr int NJOBS = 15;
__constant__ Job c_jobs[NJOBS] = {
    {4, 1024, 5632, 5632, 1, 0, WS_FF1IN},   {5, 2816, 1024, 1024, 0, 0, WS_FF1OUT}, {18, 1024, 5632, 5632, 1, 0, WS_FF2IN}, {19, 2816, 1024, 1024, 0, 0, WS_FF2OUT},
    {7, 1024, 4256, 3840, 5, 0, WS_WIN},     {7, 1024, 4256, 512, 0, 1696, WS_WSBV}, {9, 384, 768, 1024, 2, 0, WS_WQ},        {11, 256, 1024, 512, 3, 0, WS_WKN},
    {11, 256, 1024, 512, 3, 64, WS_WV},      {14, 512, 1024, 1024, 0, 0, WS_WBM},    {15, 512, 1024, 1024, 0, 0, WS_WBS},     {16, 1024, 1024, 1024, 0, 0, WS_WOUT},
    {21, 1024, 1024, 1024, 0, 0, WS_WG},     {22, 256, 1024, 1024, 0, 0, WS_WP},     {0, 0, 0, 0, 0, 0, 0}};
__constant__ float c_invf[16] = {1.0f, 0.5623413251903491f, 0.31622776601683794f, 0.1778279410038923f, 0.1f, 0.05623413251903491f, 0.03162277660168379f, 0.01778279410038923f,
                                 0.01f, 0.005623413251903491f, 0.0031622776601683794f, 0.001778279410038923f, 0.001f, 0.0005623413251903491f, 0.00031622776601683794f, 0.0001778279410038923f};

DI int map_col(int mode, int n0, int off) {
    if (mode == 0) return n0 + off;
    if (mode == 1) { const int pn = n0 >> 8, half = (n0 >> 7) & 1, j = n0 & 127; return half * FF + pn * 128 + j; }
    if (mode == 2) { const int h = n0 >> 7, j = n0 & 127; return j < 96 ? h * 96 + j : -1; }
    if (mode == 3) { const int h = n0 >> 6, j = n0 & 63; return h * 128 + j + off; }
    if (n0 < 672) return n0;
    if (n0 < 768) return -1;
    if (n0 < 1792) return n0 - 96;
    return n0 + 416;
}

DI void transpose_item(const float* W, int K, int Nsrc, bf16* WT, int n0, int sc, int k0, LAS float* scr, int lane) {
#pragma unroll 8
    for (int i = 0; i < 32; ++i) { const int kk = 2 * i + (lane >> 5); scr[kk * 33 + (lane & 31)] = (sc >= 0) ? W[(size_t)(k0 + kk) * Nsrc + sc + (lane & 31)] : 0.f; }
    asm volatile("s_waitcnt lgkmcnt(0)" ::: "memory");
    const int c = lane & 7;
#pragma unroll
    for (int j = 0; j < 4; ++j) { const int n = (lane >> 3) + 8 * j; const LAS float* s = scr + (8 * c) * 33 + n;
        u32x4 o; o.x = pk2(s[0 * 33], s[1 * 33]); o.y = pk2(s[2 * 33], s[3 * 33]); o.z = pk2(s[4 * 33], s[5 * 33]); o.w = pk2(s[6 * 33], s[7 * 33]);
        *(u32x4*)(WT + (size_t)(n0 + n) * K + k0 + 8 * c) = o; }
    asm volatile("s_waitcnt lgkmcnt(0)" ::: "memory");
}

DI void prep_weights(const Params& P, LAS uchar* lds, int gw, int NGW, int wave, int lane) {
    LAS float* scr = (LAS float*)(lds + wave * 16384);
    int total = 0;
    for (int j = 0; j < NJOBS - 1; ++j) total += (c_jobs[j].K >> 6) * (c_jobs[j].Ndst >> 5);
    for (int it = gw; it < total; it += NGW) {
        int r = it, j = 0;
        for (; j < NJOBS - 1; ++j) { const int n = (c_jobs[j].K >> 6) * (c_jobs[j].Ndst >> 5); if (r < n) break; r -= n; }
        const int K = c_jobs[j].K, Nsrc = c_jobs[j].Nsrc, nblk = c_jobs[j].Ndst >> 5, mode = c_jobs[j].mode, off = c_jobs[j].off;
        const int kb = r / nblk, nb = r % nblk, n0 = nb * 32;
        const float* W = P.in[c_jobs[j].src];
        bf16* WT = (bf16*)(P.ws + c_jobs[j].dst);
        transpose_item(W, K, Nsrc, WT, n0, map_col(mode, n0, off), kb * 64, scr, lane);
    }
}

DI void rms_row_1024(const float* xrow, const float* gain, bf16* orow, int lane) {
    const f32x4* xr = (const f32x4*)xrow + lane;
    f32x4 v[4]; float s = 0.f;
#pragma unroll
    for (int j = 0; j < 4; ++j) { v[j] = xr[64 * j]; s += (v[j].x * v[j].x + v[j].y * v[j].y) + (v[j].z * v[j].z + v[j].w * v[j].w); }
    const float r = 1.0f / sqrtf(wave_sum(s) * (1.f / 1024.f) + NORM_EPS);
    u32x2* o8 = (u32x2*)orow + lane;
#pragma unroll
    for (int j = 0; j < 4; ++j) { const f32x4 g = ((const f32x4*)gain)[64 * j + lane]; u32x2 w; w.x = pk2((v[j].x * r) * g.x, (v[j].y * r) * g.y); w.y = pk2((v[j].z * r) * g.z, (v[j].w * r) * g.w); o8[64 * j] = w; }
}
DI void norm_phase(const float* X, const float* gain, bf16* O, int gw, int NGW, int lane) {
    for (int m = gw; m < T; m += NGW) rms_row_1024(X + (size_t)m * DM, gain, O + (size_t)m * DM, lane);
}
template <int NJ> DI void latent_norm_phase(bf16* X, const float* gain, int gw, int NGW, int lane) {
    for (int m = gw; m < T; m += NGW) {
        unsigned* row = (unsigned*)(X + (size_t)m * (128 * NJ)) + lane;
        unsigned u[NJ]; float s = 0.f;
#pragma unroll
        for (int j = 0; j < NJ; ++j) { u[j] = row[64 * j]; const float a = bf_lo(u[j]), b = bf_hi(u[j]); s += a * a + b * b; }
        const float r = 1.0f / sqrtf(wave_sum(s) * (1.f / (128.f * NJ)) + NORM_EPS);
#pragma unroll
        for (int j = 0; j < NJ; ++j) { const f32x2 g = ((const f32x2*)gain)[64 * j + lane]; row[64 * j] = pk2((bf_lo(u[j]) * r) * g.x, (bf_hi(u[j]) * r) * g.y); }
    }
}
DI void cvt_phase(const float* X, bf16* O, size_t n8, size_t gtid, size_t NT) {
    for (size_t i = gtid; i < n8; i += NT) { const f32x4 a = ((const f32x4*)X)[2 * i], b = ((const f32x4*)X)[2 * i + 1]; ((u32x4*)O)[i] = pack8(a, b); }
}

DI void qk_phase(bf16* Qm, bf16* Km, const float* KR, const int* positions, const float* gq, const float* gk, int gtid, int NT) {
    for (int it = gtid; it < 2 * T * 8; it += NT) {
        const bool isk = it >= T * 8; const int e = isk ? it - T * 8 : it; const int t = e >> 3;
        bf16* base = (isk ? Km : Qm) + (size_t)e * 96;
        float v[96];
#pragma unroll
        for (int c = 0; c < 8; ++c) { const u32x4 w = ((const u32x4*)base)[c];
            v[8 * c + 0] = bf_lo(w.x); v[8 * c + 1] = bf_hi(w.x); v[8 * c + 2] = bf_lo(w.y); v[8 * c + 3] = bf_hi(w.y); v[8 * c + 4] = bf_lo(w.z); v[8 * c + 5] = bf_hi(w.z); v[8 * c + 6] = bf_lo(w.w); v[8 * c + 7] = bf_hi(w.w); }
        if (isk) {
#pragma unroll
            for (int c = 0; c < 8; ++c) { const f32x4 w = ((const f32x4*)(KR + (size_t)t * 32))[c]; v[64 + 4 * c] = w.x; v[65 + 4 * c] = w.y; v[66 + 4 * c] = w.z; v[67 + 4 * c] = w.w; }
        } else {
#pragma unroll
            for (int c = 8; c < 12; ++c) { const u32x4 w = ((const u32x4*)base)[c];
                v[8 * c + 0] = bf_lo(w.x); v[8 * c + 1] = bf_hi(w.x); v[8 * c + 2] = bf_lo(w.y); v[8 * c + 3] = bf_hi(w.y); v[8 * c + 4] = bf_lo(w.z); v[8 * c + 5] = bf_hi(w.z); v[8 * c + 6] = bf_lo(w.w); v[8 * c + 7] = bf_hi(w.w); }
        }
        float ss = 0.f;
#pragma unroll
        for (int d = 0; d < 96; ++d) ss += v[d] * v[d];
        const float r = 1.0f / sqrtf(ss * (1.f / 96.f) + NORM_EPS);
        const float* g = isk ? gk : gq;
#pragma unroll
        for (int d = 0; d < 96; ++d) v[d] = (v[d] * r) * g[d];
        const float posf = (float)positions[t];
#pragma unroll
        for (int i = 0; i < 16; ++i) {
            const float ang = posf * c_invf[i];
            const double rev = (double)ang * 0.15915494309189535;
            const float fr = (float)(rev - rint(rev));
            const float cs = __builtin_amdgcn_cosf(fr), sn = __builtin_amdgcn_sinf(fr);
            const float x1 = v[64 + i], x2 = v[80 + i];
            v[64 + i] = x1 * cs - x2 * sn; v[80 + i] = x2 * cs + x1 * sn;
        }
        const float sc = isk ? 1.0f : QSCALE_MLA;
#pragma unroll
        for (int c = 0; c < 12; ++c) { u32x4 w; w.x = pk2(v[8 * c] * sc, v[8 * c + 1] * sc); w.y = pk2(v[8 * c + 2] * sc, v[8 * c + 3] * sc); w.z = pk2(v[8 * c + 4] * sc, v[8 * c + 5] * sc); w.w = pk2(v[8 * c + 6] * sc, v[8 * c + 7] * sc);
            ((u32x4*)base)[c] = w; }
    }
}

enum { M_SWIGLU = 0, M_RESID, M_INPROJ, M_QUP, M_KNOPE, M_VT, M_GATEMUL, M_GATEADD, M_SIGM, M_FINAL };
template <int MODE> struct Epi {
    static constexpr bool PERM = true, AFTER_DRAIN = false;
    void* o0; void* o1; void* o2; void* o3; void* o4; void* o5; const void* i0; const void* i1; float alpha; int goff;
    __device__ __forceinline__ void operator()(const pg8::f32x4 (&acc)[2][2][4][2], const pg8::Unit& u, int wr, int wc, int fr, int fq) const {
#pragma unroll
        for (int ai = 0; ai < 2; ++ai)
#pragma unroll
            for (int m = 0; m < 4; ++m) {
                const int row = u.pm * 256 + ai * 128 + wr * 64 + m * 16 + fr;
                if constexpr (MODE == M_SWIGLU) {
                    const int col = u.pn * 128 + wc * 32 + 8 * fq;
                    f32x4 a0 = acc[ai][0][m][0], a1 = acc[ai][0][m][1]; const f32x4 b0 = acc[ai][1][m][0], b1 = acc[ai][1][m][1];
#pragma unroll
                    for (int i = 0; i < 4; ++i) { a0[i] = a0[i] * sigmoidf_(a0[i]) * b0[i]; a1[i] = a1[i] * sigmoidf_(a1[i]) * b1[i]; }
                    *(u32x4*)((bf16*)o0 + (size_t)row * FF + col) = pack8(a0, a1);
                } else {
#pragma unroll
                    for (int bj = 0; bj < 2; ++bj) {
                        const int col0 = u.pn * 256 + bj * 128 + wc * 32 + 8 * fq;
                        f32x4 v0 = acc[ai][bj][m][0], v1 = acc[ai][bj][m][1];
                        if constexpr (MODE == M_RESID) {
                            const size_t off = (size_t)row * DM + col0;
                            const f32x4 b0 = *(const f32x4*)((const float*)i0 + off), b1 = *(const f32x4*)((const float*)i0 + off + 4);
                            *(f32x4*)((float*)o0 + off) = b0 + v0 * alpha; *(f32x4*)((float*)o0 + off + 4) = b1 + v1 * alpha;
                        } else if constexpr (MODE == M_INPROJ) {
                            if (col0 < 384) { *(u32x4*)((bf16*)o0 + (size_t)row * 384 + col0) = pack8(v0, v1); }
                            else if (col0 < 640) { *(u32x4*)((bf16*)o1 + (size_t)row * 256 + (col0 - 384)) = pack8(v0, v1); }
                            else if (col0 < 672) { float* kr = (float*)o2 + (size_t)row * 32 + (col0 - 640); *(f32x4*)kr = v0; *(f32x4*)(kr + 4) = v1; }
                            else if (col0 < 768) { }
                            else if (col0 < 1280) { *(u32x4*)((bf16*)o3 + (size_t)row * 512 + (col0 - 768)) = pack8(v0 * QSCALE_SB, v1 * QSCALE_SB); }
                            else if (col0 < 1792) { *(u32x4*)((bf16*)o4 + (size_t)row * 512 + (col0 - 1280)) = pack8(v0, v1); }
                            else {
#pragma unroll
                                for (int i = 0; i < 4; ++i) { v0[i] = sigmoidf_(v0[i]); v1[i] = sigmoidf_(v1[i]); }
                                *(u32x4*)((bf16*)o5 + (size_t)row * 2048 + (col0 - 1792)) = pack8(v0, v1); }
                        } else if constexpr (MODE == M_QUP) {
                            const int hd = col0 >> 7, d = col0 & 127;
                            if (d < 96) *(u32x4*)((bf16*)o0 + (size_t)row * 768 + hd * 96 + d) = pack8(v0, v1);
                        } else if constexpr (MODE == M_KNOPE) {
                            const int hd = col0 >> 6, d = col0 & 63;
                            *(u32x4*)((bf16*)o0 + (size_t)row * 768 + hd * 96 + d) = pack8(v0, v1);
                        } else if constexpr (MODE == M_VT) {
                            *(u32x4*)((bf16*)o0 + (size_t)(col0 >> 12) * (512 * 4096) + (size_t)row * 4096 + (col0 & 4095)) = pack8(v0, v1);
                        } else if constexpr (MODE == M_GATEMUL) {
                            const u32x4 g = *(const u32x4*)((const bf16*)i0 + (size_t)row * 2048 + goff + col0);
                            const size_t off = (size_t)row * DM + col0;
                            v0[0] *= bf_lo(g.x); v0[1] *= bf_hi(g.x); v0[2] *= bf_lo(g.y); v0[3] *= bf_hi(g.y); v1[0] *= bf_lo(g.z); v1[1] *= bf_hi(g.z); v1[2] *= bf_lo(g.w); v1[3] *= bf_hi(g.w);
                            *(f32x4*)((float*)o0 + off) = v0; *(f32x4*)((float*)o0 + off + 4) = v1;
                        } else if constexpr (MODE == M_GATEADD) {
                            const u32x4 g = *(const u32x4*)((const bf16*)i0 + (size_t)row * 2048 + goff + col0);
                            const size_t off = (size_t)row * DM + col0;
                            const f32x4 t0 = *(const f32x4*)((const float*)i1 + off), t1 = *(const f32x4*)((const float*)i1 + off + 4);
                            v0[0] = t0[0] + v0[0] * bf_lo(g.x); v0[1] = t0[1] + v0[1] * bf_hi(g.x); v0[2] = t0[2] + v0[2] * bf_lo(g.y); v0[3] = t0[3] + v0[3] * bf_hi(g.y);
                            v1[0] = t1[0] + v1[0] * bf_lo(g.z); v1[1] = t1[1] + v1[1] * bf_hi(g.z); v1[2] = t1[2] + v1[2] * bf_lo(g.w); v1[3] = t1[3] + v1[3] * bf_hi(g.w);
                            *(u32x4*)((bf16*)o0 + off) = pack8(v0, v1);
                        } else if constexpr (MODE == M_SIGM) {
                            const size_t off = (size_t)row * DM + col0;
#pragma unroll
                            for (int i = 0; i < 4; ++i) { v0[i] = sigmoidf_(v0[i]); v1[i] = sigmoidf_(v1[i]); }
                            *(f32x4*)((float*)o0 + off) = v0; *(f32x4*)((float*)o0 + off + 4) = v1;
                        } else if constexpr (MODE == M_FINAL) {
                            const size_t off = (size_t)row * DM + col0;
                            const f32x4 t0 = *(const f32x4*)((const float*)i1 + off), t1 = *(const f32x4*)((const float*)i1 + off + 4);
                            const f32x4 b0 = *(const f32x4*)((const float*)i0 + off), b1 = *(const f32x4*)((const float*)i0 + off + 4);
                            *(f32x4*)((float*)o0 + off) = b0 + t0 * v0; *(f32x4*)((float*)o0 + off + 4) = b1 + t1 * v1;
                        }
                    }
                }
            }
    }
};
template <int MODE> DI void run_gemm(LAS uchar* lds, const bf16* A, const bf16* Bt, int M, int N, int K, const Epi<MODE>& E) {
    asm volatile("" : "+s"(M), "+s"(N), "+s"(K));
    pg8::Gemm g{A, Bt, M, N, K}; pg8::StaticOrder S; S.init(M, N, (int)gridDim.x, (int)blockIdx.x);
    pg8::gemm_phase<Epi<MODE>, pg8::StaticOrder, PG8_ALIGN, PG8_SP2>(lds, g, S, E);
}

DI int crow(int reg, int h) { return (reg & 3) + 8 * (reg >> 2) + 4 * h; }
constexpr int KP_MLA = 208, KP_SB = 144, VP = 144;
constexpr int LDS_K = 0, LDS_V = 16384, LDS_FLAGS = 32768;

DI void mla_unit(LAS uchar* lds, const bf16* Qm, const bf16* Km, const bf16* Vt, bf16* O, int bh, int qb, int tid, int wid, int lane) {
    const int b = bh >> 3, hd = bh & 7, r = lane & 31, h = lane >> 5;
    const size_t tbase = (size_t)b * SEQ;
    const int q0 = qb * 256 + wid * 32;
    bf16x8 qf[6];
    { const bf16* qp = Qm + (tbase + q0 + r) * 768 + hd * 96 + 8 * h;
#pragma unroll
      for (int kb = 0; kb < 6; ++kb) qf[kb] = *(const bf16x8*)(qp + 16 * kb); }
    f32x16 o0, o1;
#pragma unroll
    for (int i = 0; i < 16; ++i) { o0[i] = 0.f; o1[i] = 0.f; }
    float mrun = -INFINITY, lrun = 0.f;
    const int nt = 4 * (qb + 1), jmax = 4 * qb + (wid >> 1);
    const int kr0 = tid / 12, kc0 = tid % 12, kr1 = (tid + 512) / 12, kc1 = (tid + 512) % 12;
    const bf16* kg = Km + tbase * 768 + hd * 96;
    const bf16* vg = Vt + ((size_t)bh * 64 + (tid >> 3)) * SEQ + (tid & 7) * 8;
    u32x4 ka, kb2 = {0u, 0u, 0u, 0u}, va;
    ka = *(const u32x4*)(kg + (size_t)kr0 * 768 + kc0 * 8); if (tid < 256) kb2 = *(const u32x4*)(kg + (size_t)kr1 * 768 + kc1 * 8); va = *(const u32x4*)(vg);
    LAS uchar* ldsK = lds + LDS_K; LAS uchar* ldsV = lds + LDS_V;
    for (int j = 0; j < nt; ++j) {
        __syncthreads();
        *(LAS u32x4*)(ldsK + kr0 * KP_MLA + kc0 * 16) = ka; if (tid < 256) *(LAS u32x4*)(ldsK + kr1 * KP_MLA + kc1 * 16) = kb2;
        *(LAS u32x4*)(ldsV + (tid >> 3) * VP + (tid & 7) * 16) = va;
        __syncthreads();
        if (j + 1 < nt) { const size_t ko = (size_t)(64 * (j + 1)) * 768;
            ka = *(const u32x4*)(kg + ko + (size_t)kr0 * 768 + kc0 * 8); if (tid < 256) kb2 = *(const u32x4*)(kg + ko + (size_t)kr1 * 768 + kc1 * 8); va = *(const u32x4*)(vg + 64 * (j + 1)); }
        if (j <= jmax) {
            f32x16 s0, s1;
#pragma unroll
            for (int i = 0; i < 16; ++i) { s0[i] = 0.f; s1[i] = 0.f; }
#pragma unroll
            for (int kb = 0; kb < 6; ++kb) {
                const bf16x8 a0 = *(const LAS bf16x8*)(ldsK + r * KP_MLA + (16 * kb + 8 * h) * 2);
                const bf16x8 a1 = *(const LAS bf16x8*)(ldsK + (32 + r) * KP_MLA + (16 * kb + 8 * h) * 2);
                s0 = MFMA32(a0, qf[kb], s0); s1 = MFMA32(a1, qf[kb], s1);
            }
            if (j == jmax) { const int tq = q0 + r - 64 * j;
#pragma unroll
                for (int i = 0; i < 16; ++i) { if (crow(i, h) > tq) s0[i] = -INFINITY; if (32 + crow(i, h) > tq) s1[i] = -INFINITY; } }
            float mx = s0[0];
#pragma unroll
            for (int i = 1; i < 16; ++i) mx = fmaxf(mx, s0[i]);
#pragma unroll
            for (int i = 0; i < 16; ++i) mx = fmaxf(mx, s1[i]);
            mx = fmaxf(mx, __shfl_xor(mx, 32));
            const float mnew = fmaxf(mrun, mx);
            const float alpha = __builtin_amdgcn_exp2f(mrun - mnew); mrun = mnew;
            float ls = 0.f;
#pragma unroll
            for (int i = 0; i < 16; ++i) { s0[i] = __builtin_amdgcn_exp2f(s0[i] - mnew); s1[i] = __builtin_amdgcn_exp2f(s1[i] - mnew); ls += s0[i] + s1[i]; }
            lrun = lrun * alpha + ls;
#pragma unroll
            for (int i = 0; i < 16; ++i) { o0[i] *= alpha; o1[i] *= alpha; }
#pragma unroll
            for (int sub = 0; sub < 2; ++sub)
#pragma unroll
                for (int s = 0; s < 2; ++s) {
                    u32x4 pw;
                    if (sub == 0) { pw.x = pk2(s0[8 * s], s0[8 * s + 1]); pw.y = pk2(s0[8 * s + 2], s0[8 * s + 3]); pw.z = pk2(s0[8 * s + 4], s0[8 * s + 5]); pw.w = pk2(s0[8 * s + 6], s0[8 * s + 7]); }
                    else          { pw.x = pk2(s1[8 * s], s1[8 * s + 1]); pw.y = pk2(s1[8 * s + 2], s1[8 * s + 3]); pw.z = pk2(s1[8 * s + 4], s1[8 * s + 5]); pw.w = pk2(s1[8 * s + 6], s1[8 * s + 7]); }
                    const bf16x8 pb = __builtin_bit_cast(bf16x8, pw);
                    const int koff = (32 * sub + 16 * s + 4 * h) * 2;
                    { const s16x4 lo = *(const LAS s16x4*)(ldsV + r * VP + koff), hi = *(const LAS s16x4*)(ldsV + r * VP + koff + 16);
                      o0 = MFMA32(__builtin_shufflevector(lo, hi, 0, 1, 2, 3, 4, 5, 6, 7), pb, o0); }
                    { const s16x4 lo = *(const LAS s16x4*)(ldsV + (32 + r) * VP + koff), hi = *(const LAS s16x4*)(ldsV + (32 + r) * VP + koff + 16);
                      o1 = MFMA32(__builtin_shufflevector(lo, hi, 0, 1, 2, 3, 4, 5, 6, 7), pb, o1); }
                }
        }
    }
    lrun += __shfl_xor(lrun, 32);
    const float inv = 1.0f / lrun;
    bf16* op = O + (tbase + q0 + r) * 512 + hd * 64 + 4 * h;
#pragma unroll
    for (int g = 0; g < 4; ++g) {
        u32x2 w0, w1; w0.x = pk2(o0[4 * g] * inv, o0[4 * g + 1] * inv); w0.y = pk2(o0[4 * g + 2] * inv, o0[4 * g + 3] * inv);
        w1.x = pk2(o1[4 * g] * inv, o1[4 * g + 1] * inv); w1.y = pk2(o1[4 * g + 2] * inv, o1[4 * g + 3] * inv);
        *(u32x2*)(op + 8 * g) = w0; *(u32x2*)(op + 32 + 8 * g) = w1;
    }
}

DI void sb_subtile(f32x16& z, bool diag, int tq, int koffs, int h, float& carry) {
    float L[16];
#pragma unroll
    for (int i = 0; i < 16; ++i) { const bool msk = diag && (koffs + crow(i, h) >= tq); const float E = __builtin_amdgcn_exp2f(fminf(z[i], 100.f)); L[i] = msk ? 0.f : __builtin_amdgcn_logf(1.0f + E); if (msk) z[i] = -INFINITY; }
    float G[4], PG[4];
#pragma unroll
    for (int g = 0; g < 4; ++g) { G[g] = (L[4 * g] + L[4 * g + 1]) + (L[4 * g + 2] + L[4 * g + 3]); PG[g] = __shfl_xor(G[g], 32); }
    float R = carry;
#pragma unroll
    for (int g = 3; g >= 0; --g) {
        const float e3 = R + (h == 0 ? PG[g] : 0.f), e2 = e3 + L[4 * g + 3], e1 = e2 + L[4 * g + 2], e0 = e1 + L[4 * g + 1];
        z[4 * g + 3] = __builtin_amdgcn_exp2f(z[4 * g + 3] - L[4 * g + 3] - e3);
        z[4 * g + 2] = __builtin_amdgcn_exp2f(z[4 * g + 2] - L[4 * g + 2] - e2);
        z[4 * g + 1] = __builtin_amdgcn_exp2f(z[4 * g + 1] - L[4 * g + 1] - e1);
        z[4 * g + 0] = __builtin_amdgcn_exp2f(z[4 * g + 0] - L[4 * g + 0] - e0);
        R += G[g] + PG[g];
    }
    carry = R;
}
DI void sb_unit(LAS uchar* lds, const bf16* Qs, const bf16* Ks, const bf16* Vt, bf16* O, int bh, int qb, int tid, int wid, int lane) {
    const int b = bh >> 3, hd = bh & 7, r = lane & 31, h = lane >> 5;
    const size_t tbase = (size_t)b * SEQ;
    const int q0 = qb * 256 + wid * 32;
    bf16x8 qf[4];
    { const bf16* qp = Qs + (tbase + q0 + r) * 512 + hd * 64 + 8 * h;
#pragma unroll
      for (int kb = 0; kb < 4; ++kb) qf[kb] = *(const bf16x8*)(qp + 16 * kb); }
    f32x16 o0, o1;
#pragma unroll
    for (int i = 0; i < 16; ++i) { o0[i] = 0.f; o1[i] = 0.f; }
    float carry = 0.f;
    const int nt = 4 * (qb + 1), jmax = 4 * qb + (wid >> 1);
    const bf16* kg = Ks + (tbase + (tid >> 3)) * 512 + hd * 64 + (tid & 7) * 8;
    const bf16* vg = Vt + ((size_t)bh * 64 + (tid >> 3)) * SEQ + (tid & 7) * 8;
    u32x4 ka, va;
    ka = *(const u32x4*)(kg + (size_t)(64 * (nt - 1)) * 512); va = *(const u32x4*)(vg + 64 * (nt - 1));
    LAS uchar* ldsK = lds + LDS_K; LAS uchar* ldsV = lds + LDS_V; volatile LAS unsigned* flags = (volatile LAS unsigned*)(lds + LDS_FLAGS);
    bool done = false;
    if (lane == 0) flags[wid] = 0u;
    for (int jj = 0; jj < nt; ++jj) {
        const int j = nt - 1 - jj;
        __syncthreads();
        if (jj > 0) { unsigned all = 1u;
#pragma unroll
            for (int w = 0; w < 8; ++w) all &= flags[w];
            if (all) break; }
        *(LAS u32x4*)(ldsK + (tid >> 3) * KP_SB + (tid & 7) * 16) = ka;
        *(LAS u32x4*)(ldsV + (tid >> 3) * VP + (tid & 7) * 16) = va;
        __syncthreads();
        if (j > 0) { ka = *(const u32x4*)(kg + (size_t)(64 * (j - 1)) * 512); va = *(const u32x4*)(vg + 64 * (j - 1)); }
        if (j <= jmax && !done) {
            f32x16 s0, s1;
#pragma unroll
            for (int i = 0; i < 16; ++i) { s0[i] = 0.f; s1[i] = 0.f; }
#pragma unroll
            for (int kb = 0; kb < 4; ++kb) {
                const bf16x8 a0 = *(const LAS bf16x8*)(ldsK + r * KP_SB + (16 * kb + 8 * h) * 2);
                const bf16x8 a1 = *(const LAS bf16x8*)(ldsK + (32 + r) * KP_SB + (16 * kb + 8 * h) * 2);
                s0 = MFMA32(a0, qf[kb], s0); s1 = MFMA32(a1, qf[kb], s1);
            }
            const int tq = q0 + r - 64 * j; const bool diag = (j == jmax);
            sb_subtile(s1, diag, tq, 32, h, carry);
            sb_subtile(s0, diag, tq, 0, h, carry);
#pragma unroll
            for (int sub = 0; sub < 2; ++sub)
#pragma unroll
                for (int s = 0; s < 2; ++s) {
                    u32x4 pw;
                    if (sub == 0) { pw.x = pk2(s0[8 * s], s0[8 * s + 1]); pw.y = pk2(s0[8 * s + 2], s0[8 * s + 3]); pw.z = pk2(s0[8 * s + 4], s0[8 * s + 5]); pw.w = pk2(s0[8 * s + 6], s0[8 * s + 7]); }
                    else          { pw.x = pk2(s1[8 * s], s1[8 * s + 1]); pw.y = pk2(s1[8 * s + 2], s1[8 * s + 3]); pw.z = pk2(s1[8 * s + 4], s1[8 * s + 5]); pw.w = pk2(s1[8 * s + 6], s1[8 * s + 7]); }
                    const bf16x8 pb = __builtin_bit_cast(bf16x8, pw);
                    const int koff = (32 * sub + 16 * s + 4 * h) * 2;
                    { const s16x4 lo = *(const LAS s16x4*)(ldsV + r * VP + koff), hi = *(const LAS s16x4*)(ldsV + r * VP + koff + 16);
                      o0 = MFMA32(__builtin_shufflevector(lo, hi, 0, 1, 2, 3, 4, 5, 6, 7), pb, o0); }
                    { const s16x4 lo = *(const LAS s16x4*)(ldsV + (32 + r) * VP + koff), hi = *(const LAS s16x4*)(ldsV + (32 + r) * VP + koff + 16);
                      o1 = MFMA32(__builtin_shufflevector(lo, hi, 0, 1, 2, 3, 4, 5, 6, 7), pb, o1); }
                }
            done = __builtin_amdgcn_ballot_w64(carry > 160.f) == ~0ull;
        }
        if (lane == 0) flags[wid] = done ? 1u : 0u;
    }
    __syncthreads();
    bf16* op = O + (tbase + q0 + r) * 512 + hd * 64 + 4 * h;
#pragma unroll
    for (int g = 0; g < 4; ++g) {
        u32x2 w0, w1; w0.x = pk2(o0[4 * g], o0[4 * g + 1]); w0.y = pk2(o0[4 * g + 2], o0[4 * g + 3]);
        w1.x = pk2(o1[4 * g], o1[4 * g + 1]); w1.y = pk2(o1[4 * g + 2], o1[4 * g + 3]);
        *(u32x2*)(op + 8 * g) = w0; *(u32x2*)(op + 32 + 8 * g) = w1;
    }
}

__global__ void __launch_bounds__(512, 2) mega_fwd(Params P) {
    extern __shared__ __attribute__((aligned(16))) unsigned char lds_raw[];
    LAS uchar* lds = (LAS uchar*)lds_raw;
    cg::grid_group grid = cg::this_grid();
    const int G = gridDim.x, NGW = G * 8, NT = G * 512;
#define FRESH() int tid = threadIdx.x; asm volatile("" : "+v"(tid)); const int lane = tid & 63, wave = __builtin_amdgcn_readfirstlane(tid >> 6), gw = blockIdx.x * 8 + wave, gtid = blockIdx.x * 512 + tid; (void)lane; (void)gw; (void)gtid;
    unsigned char* ws = P.ws;
    const float* x = P.in[0];
    bf16* XN = (bf16*)(ws + WS_XN); float* H = (float*)(ws + WS_H); bf16* ACT = (bf16*)(ws + WS_ACT);
    bf16* CQ = (bf16*)(ws + WS_CQ); bf16* CKV = (bf16*)(ws + WS_CKV); float* KR = (float*)(ws + WS_KR);
    bf16* SBQ = (bf16*)(ws + WS_SBQ); bf16* SBK = (bf16*)(ws + WS_SBK); bf16* VTS = (bf16*)(ws + WS_VTS);
    bf16* QM = (bf16*)(ws + WS_QM); bf16* KM = (bf16*)(ws + WS_KM); bf16* VTM = (bf16*)(ws + WS_VTM);
    bf16* OM = (bf16*)(ws + WS_OM); bf16* OS = SBQ; bf16* MERGED = (bf16*)(ws + WS_MERGED); float* TMP = (float*)(ws + WS_TMP); bf16* PB = (bf16*)(ws + WS_PB);
    bf16* GATES = (bf16*)P.out;

    { FRESH(); prep_weights(P, lds, gw, NGW, wave, lane); }
    { FRESH(); norm_phase(x, P.in[3], XN, gw, NGW, lane); }
    grid.sync();
    { Epi<M_SWIGLU> E{}; E.o0 = ACT; run_gemm<M_SWIGLU>(lds, XN, (const bf16*)(ws + WS_FF1IN), T, 2 * FF, DM, E); }
    grid.sync();
    { Epi<M_RESID> E{}; E.o0 = H; E.i0 = x; E.alpha = 0.5f; run_gemm<M_RESID>(lds, ACT, (const bf16*)(ws + WS_FF1OUT), T, DM, FF, E); }
    grid.sync();
    { FRESH(); norm_phase(H, P.in[6], XN, gw, NGW, lane); }
    grid.sync();
    { Epi<M_INPROJ> E{}; E.o0 = CQ; E.o1 = CKV; E.o2 = KR; E.o3 = SBQ; E.o4 = SBK; E.o5 = GATES; run_gemm<M_INPROJ>(lds, XN, (const bf16*)(ws + WS_WIN), T, 3840, DM, E); }
    { Epi<M_VT> E{}; E.o0 = VTS; run_gemm<M_VT>(lds, (const bf16*)(ws + WS_WSBV), XN, 512, T, DM, E); }
    grid.sync();
    { FRESH(); latent_norm_phase<3>(CQ, P.in[8], gw, NGW, lane); }
    { FRESH(); latent_norm_phase<2>(CKV, P.in[10], gw, NGW, lane); }
    grid.sync();
    { Epi<M_QUP> E{}; E.o0 = QM; run_gemm<M_QUP>(lds, CQ, (const bf16*)(ws + WS_WQ), T, 1024, 384, E); }
    { Epi<M_KNOPE> E{}; E.o0 = KM; run_gemm<M_KNOPE>(lds, CKV, (const bf16*)(ws + WS_WKN), T, 512, 256, E); }
    { Epi<M_VT> E{}; E.o0 = VTM; run_gemm<M_VT>(lds, (const bf16*)(ws + WS_WV), CKV, 512, T, 256, E); }
    grid.sync();
    { FRESH(); qk_phase(QM, KM, KR, (const int*)P.in[2], P.in[12], P.in[13], gtid, NT); }
    grid.sync();
    { FRESH(); for (int pp = blockIdx.x; pp < 1024; pp += G) { const int c = pp & 255, k = pp >> 8, bh = c >> 2, s = c & 3;
        const int qb = k == 0 ? 15 - s : (k == 1 ? 8 + s : (k == 2 ? 7 - s : s));
        mla_unit(lds, QM, KM, VTM, OM, bh, qb, tid, wave, lane); } }
    { FRESH(); for (int uu = blockIdx.x; uu < 1024; uu += G) sb_unit(lds, SBQ, SBK, VTS, OS, uu >> 4, uu & 15, tid, wave, lane); }
    __syncthreads();
    grid.sync();
    { Epi<M_GATEMUL> E{}; E.o0 = TMP; E.i0 = GATES; E.goff = 0; run_gemm<M_GATEMUL>(lds, OM, (const bf16*)(ws + WS_WBM), T, DM, 512, E); }
    { Epi<M_GATEADD> E{}; E.o0 = MERGED; E.i0 = GATES; E.i1 = TMP; E.goff = 1024; run_gemm<M_GATEADD>(lds, OS, (const bf16*)(ws + WS_WBS), T, DM, 512, E); }
    grid.sync();
    { Epi<M_RESID> E{}; E.o0 = H; E.i0 = H; E.alpha = 1.0f; run_gemm<M_RESID>(lds, MERGED, (const bf16*)(ws + WS_WOUT), T, DM, DM, E); }
    grid.sync();
    { FRESH(); norm_phase(H, P.in[17], XN, gw, NGW, lane); }
    grid.sync();
    { Epi<M_SWIGLU> E{}; E.o0 = ACT; run_gemm<M_SWIGLU>(lds, XN, (const bf16*)(ws + WS_FF2IN), T, 2 * FF, DM, E); }
    grid.sync();
    { Epi<M_RESID> E{}; E.o0 = P.out; E.i0 = H; E.alpha = 0.5f; run_gemm<M_RESID>(lds, ACT, (const bf16*)(ws + WS_FF2OUT), T, DM, FF, E); }
    grid.sync();
    { FRESH(); norm_phase(P.out, P.in[20], XN, gw, NGW, lane); }
    { FRESH(); cvt_phase(P.in[1], PB, (size_t)T * 256 / 8, (size_t)gtid, (size_t)NT); }
    grid.sync();
    { Epi<M_SIGM> E{}; E.o0 = TMP; run_gemm<M_SIGM>(lds, XN, (const bf16*)(ws + WS_WG), T, DM, DM, E); }
    { Epi<M_FINAL> E{}; E.o0 = P.out; E.i0 = P.out; E.i1 = TMP; run_gemm<M_FINAL>(lds, PB, (const bf16*)(ws + WS_WP), T, DM, 256, E); }
}

extern "C" void kernel_launch(void* const* d_in, const int* in_sizes, int n_in, void* d_out, int out_size, void* d_ws, size_t ws_size, hipStream_t stream) {
    static int grid = 0;
    if (grid == 0) {
        if (n_in != 23 || ws_size < WS_END) { fprintf(stderr, "kernel_launch: unexpected n_in %d / ws_size %zu\n", n_in, ws_size); grid = -1; return; }
        int dev = 0, cus = 0, per_cu = 0;
        hipGetDevice(&dev); hipDeviceGetAttribute(&cus, hipDeviceAttributeMultiprocessorCount, dev);
        if (hipFuncSetAttribute((const void*)mega_fwd, hipFuncAttributeMaxDynamicSharedMemorySize, LDS_BYTES) != hipSuccess) { fprintf(stderr, "hipFuncSetAttribute failed\n"); grid = -1; return; }
        if (hipOccupancyMaxActiveBlocksPerMultiprocessor(&per_cu, (const void*)mega_fwd, 512, LDS_BYTES) != hipSuccess || per_cu < 1) { fprintf(stderr, "occupancy query: %d\n", per_cu); per_cu = 1; }
        (void)hipGetLastError();
        grid = cus * per_cu;
    }
    if (grid < 0) return;
    Params p{};
    for (int i = 0; i < 23; ++i) p.in[i] = (const float*)d_in[i];
    p.out = (float*)d_out; p.ws = (unsigned char*)d_ws;
    void* args[] = {&p};
    hipError_t e = hipLaunchCooperativeKernel((const void*)mega_fwd, dim3(grid), dim3(512), args, LDS_BYTES, stream);
    if (e != hipSuccess) fprintf(stderr, "cooperative launch failed: %s (grid %d)\n", hipGetErrorString(e), grid);
}
```

```cpp
#include <hip/hip_runtime.h>
#include <hip/hip_cooperative_groups.h>
#include <cstdio>
#include <cstdint>
namespace cg = cooperative_groups;
namespace pg8 {
#define PG8_LAS __attribute__((address_space(3)))
typedef unsigned short bf16_t;
typedef short bf16x8 __attribute__((ext_vector_type(8)));
typedef float f32x4 __attribute__((ext_vector_type(4)));
typedef unsigned u32x4 __attribute__((ext_vector_type(4)));
constexpr int BM = 256, BK = 64, HALF = 128, HTB = HALF * BK * 2  , STAGE_BYTES = 8 * HTB, NXCD = 8, WGM = 8;

__host__ __device__ __forceinline__ int lds_byte(int r, int c) { const int st = (r >> 4) * 2 + (c >> 5), rr = r & 15, cc = c & 31, ob = rr * 64 + cc * 2; return st * 1024 + (ob ^ (((ob >> 9) & 1) << 5)); }
__host__ __device__ __forceinline__ void stage_rc(int b, int& R, int& C) { const int st = b / 1024, sb = b % 1024, swz = sb ^ (((sb >> 9) & 1) << 5); R = (st >> 1) * 16 + swz / 64; C = (st & 1) * 32 + (swz % 64) / 2; }
__host__ __device__ __forceinline__ int perm32(int rho) { const int n = rho >> 4, i = rho & 15; return 8 * (i >> 2) + 4 * n + (i & 3); }

struct Unit { int pm, pn, half; };
struct Gemm { const bf16_t* A; const bf16_t* Bt; int M, N, K; const bf16_t* A2; const bf16_t* Bt2; };

struct StaticOrder {
    int nM, nN, nwg, G, c;
    __host__ __device__ void init(int M, int N, int G_, int c_) { nM = M / BM; nN = N / BM; nwg = nM * nN; G = G_; c = c_; }
    __host__ __device__ bool next(int i, Unit& u) const {
        const long L = (long)i * G + c; if (L >= nwg) return false;
        int wgid = (int)L; { const int q = nwg / NXCD, r = nwg % NXCD, xcd = wgid % NXCD, off = wgid / NXCD; wgid = (xcd < r ? xcd * (q + 1) : r * (q + 1) + (xcd - r) * q) + off; }
        const int nig = WGM * nN, gid = wgid / nig, fm = gid * WGM, gsz = (nM - fm) < WGM ? (nM - fm) : WGM;
        u.pm = fm + ((wgid % nig) % gsz); u.pn = (wgid % nig) / gsz; u.half = 0; return true;
    }
    __device__ __forceinline__ void a_ready(const Unit&) const {}
    __device__ __forceinline__ void done(const Unit&) const {}
};

__device__ __forceinline__ unsigned cvt_pk_bf16(float lo, float hi) { unsigned r; asm volatile("v_cvt_pk_bf16_f32 %0, %1, %2" : "=v"(r) : "v"(lo), "v"(hi)); return r; }
typedef float f32x2 __attribute__((ext_vector_type(2)));
template <class Epi, class Sched, bool ALIGN_EPI = false, bool SP2 = false>
__device__ __forceinline__ void gemm_phase(PG8_LAS unsigned char* lds, const Gemm g, const Sched& S, const Epi& E, const int wave_s) {
    unsigned z_ = 0u; asm volatile("" : "+v"(z_)); int tid_ = wave_s * 64 + (int)__builtin_amdgcn_mbcnt_hi(~0u, __builtin_amdgcn_mbcnt_lo(~0u, z_)); const int tid = tid_, wid = __builtin_amdgcn_readfirstlane(tid >> 6), lane = tid & 63, wr = wid >> 2, wc = wid & 3, fr = lane & 15, fq = lane >> 4;
    const int K = g.K, nt = K / BK;
    unsigned voffA[2], voffB[2];
#pragma unroll
    for (int i = 0; i < 2; ++i) { int R, C; stage_rc(tid * 16 + i * 8192, R, C); const int Rb = Epi::PERM ? ((R & ~31) + perm32(R & 31)) : R;
        voffA[i] = (unsigned)(R * K + C) * 2u; voffB[i] = (unsigned)(Rb * K + C) * 2u; }
    const size_t kstep = (size_t)(BK * 2);
    const size_t hstep = (size_t)HALF * K * 2;
    const size_t tstep = 2 * hstep;
    const unsigned ldsw = (unsigned)wid * 1024u;
    const int aoff = lds_byte(wr * 64 + fr, fq * 8), boff = lds_byte(wc * 32 + fr, fq * 8);
#define PG8_SA(b, h) (((b) * 2 + (h)) * HTB)
#define PG8_SB(b, h) ((4 + (b) * 2 + (h)) * HTB)
#define PG8_STAGE(bufoff, gbase, voff) do { _Pragma("unroll") for (int _i = 0; _i < 2; ++_i) \
        __builtin_amdgcn_global_load_lds((const unsigned*)((const char*)(gbase) + (voff)[_i]), (PG8_LAS unsigned*)(lds + (bufoff) + ldsw + _i * 8192), 16, 0, 0); } while (0)
#define PG8_LDA(dst, b, h) do { _Pragma("unroll") for (int m = 0; m < 4; ++m) _Pragma("unroll") for (int k = 0; k < 2; ++k) dst[m][k] = *(const PG8_LAS bf16x8*)(lds + PG8_SA(b, h) + aoff + m * 2048 + k * 1024); } while (0)
#define PG8_LDB(dst, b, h) do { _Pragma("unroll") for (int n = 0; n < 2; ++n) _Pragma("unroll") for (int k = 0; k < 2; ++k) dst[n][k] = *(const PG8_LAS bf16x8*)(lds + PG8_SB(b, h) + boff + n * 2048 + k * 1024); } while (0)
#define PG8_MMA(ai, bj, At, Bt) do { __builtin_amdgcn_s_setprio(1); _Pragma("unroll") for (int m = 0; m < 4; ++m) _Pragma("unroll") for (int n = 0; n < 2; ++n) _Pragma("unroll") for (int k = 0; k < 2; ++k) \
        acc[ai][bj][m][n] = __builtin_amdgcn_mfma_f32_16x16x32_bf16(Bt[n][k], At[m][k], acc[ai][bj][m][n], 0, 0, 0); __builtin_amdgcn_s_setprio(0); } while (0)
#define PG8_WAIT_V(n) asm volatile("s_waitcnt vmcnt(" #n ")" ::: "memory")
#define PG8_WAIT_L(n) asm volatile("s_waitcnt lgkmcnt(" #n ")" ::: "memory")
#define PG8_BAR __builtin_amdgcn_s_barrier()
#define PG8_SCHED __builtin_amdgcn_sched_barrier(0)
    Unit cur, nxt; int ui = 0;
    if (!S.next(0, cur)) return;
    f32x4 acc[2][2][4][2];
#pragma unroll
    for (int a = 0; a < 2; ++a)
#pragma unroll
        for (int b = 0; b < 2; ++b)
#pragma unroll
            for (int m = 0; m < 4; ++m)
#pragma unroll
                for (int n = 0; n < 2; ++n) acc[a][b][m][n] = (f32x4){0.f, 0.f, 0.f, 0.f};
    bf16x8 At[4][2], B0[2][2], B1[2][2];
    const char* cA = (const char*)(cur.half ? g.A2 : g.A) + (size_t)cur.pm * tstep; const char* cB = (const char*)(cur.half ? g.Bt2 : g.Bt) + (size_t)cur.pn * tstep;
    S.a_ready(cur);
    if constexpr (SP2) {
        PG8_STAGE(PG8_SB(0, 0), cB, voffB); PG8_STAGE(PG8_SB(0, 1), cB + hstep, voffB); PG8_STAGE(PG8_SA(0, 0), cA, voffA); PG8_STAGE(PG8_SA(0, 1), cA + hstep, voffA);
        if (wr == 1) PG8_BAR;
        PG8_WAIT_V(2); PG8_BAR;
        PG8_STAGE(PG8_SB(1, 0), cB + kstep, voffB); PG8_STAGE(PG8_SA(1, 0), cA + kstep, voffA); PG8_STAGE(PG8_SB(1, 1), cB + hstep + kstep, voffB);
        PG8_WAIT_V(6); PG8_BAR;
    } else {
        PG8_STAGE(PG8_SB(0, 0), cB, voffB); PG8_STAGE(PG8_SA(0, 0), cA, voffA); PG8_STAGE(PG8_SB(0, 1), cB + hstep, voffB); PG8_STAGE(PG8_SA(0, 1), cA + hstep, voffA);
        if (wr == 1) PG8_BAR;
        PG8_WAIT_V(4); PG8_BAR;
        PG8_STAGE(PG8_SB(1, 0), cB + kstep, voffB); PG8_STAGE(PG8_SA(1, 0), cA + kstep, voffA); PG8_STAGE(PG8_SB(1, 1), cB + hstep + kstep, voffB);
        PG8_WAIT_V(6); PG8_BAR;
    }
    for (;;) {
        const bool has_next = S.next(ui + 1, nxt);
        const char* nA = has_next ? (const char*)(nxt.half ? g.A2 : g.A) + (size_t)nxt.pm * tstep : cA; const char* nB = has_next ? (const char*)(nxt.half ? g.Bt2 : g.Bt) + (size_t)nxt.pn * tstep : cB;
        for (int t = 0; t < nt; t += 2) {
            const bool last = (t == nt - 2);
            const char* a1 = cA + (size_t)(t + 1) * kstep;
            const char* a2 = last ? nA : cA + (size_t)(t + 2) * kstep; const char* b2 = last ? nB : cB + (size_t)(t + 2) * kstep;
            const char* a3 = a2 + kstep; const char* b3 = b2 + kstep;
            if (last && has_next) S.a_ready(nxt);
            if constexpr (SP2) {
            PG8_LDB(B0, 0, 0); PG8_LDB(B1, 0, 1); PG8_SCHED; PG8_LDA(At, 0, 0); PG8_STAGE(PG8_SA(1, 1), a1 + hstep, voffA);
            PG8_WAIT_V(8); PG8_WAIT_L(0); PG8_BAR; PG8_MMA(0, 0, At, B0); PG8_MMA(0, 1, At, B1); PG8_BAR; PG8_SCHED;
            PG8_LDA(At, 0, 1); PG8_STAGE(PG8_SB(0, 0), b2, voffB); PG8_STAGE(PG8_SB(0, 1), b2 + hstep, voffB); PG8_STAGE(PG8_SA(0, 0), a2, voffA);
            PG8_WAIT_V(8); PG8_WAIT_L(0); PG8_BAR; PG8_MMA(1, 0, At, B0); PG8_MMA(1, 1, At, B1); PG8_BAR; PG8_SCHED;
            PG8_LDB(B0, 1, 0); PG8_LDB(B1, 1, 1); PG8_SCHED; PG8_LDA(At, 1, 0); PG8_STAGE(PG8_SA(0, 1), a2 + hstep, voffA);
            PG8_WAIT_V(8); PG8_WAIT_L(0); PG8_BAR; PG8_MMA(0, 0, At, B0); PG8_MMA(0, 1, At, B1); PG8_BAR; PG8_SCHED;
            PG8_LDA(At, 1, 1); PG8_STAGE(PG8_SB(1, 0), b3, voffB); PG8_STAGE(PG8_SB(1, 1), b3 + hstep, voffB); PG8_STAGE(PG8_SA(1, 0), a3, voffA);
            PG8_WAIT_V(8); PG8_WAIT_L(0); PG8_BAR; PG8_MMA(1, 0, At, B0); PG8_MMA(1, 1, At, B1); PG8_BAR; PG8_SCHED;
            } else {
            PG8_LDB(B0, 0, 0); PG8_SCHED; PG8_LDA(At, 0, 0); PG8_STAGE(PG8_SA(1, 1), a1 + hstep, voffA);
            PG8_WAIT_L(8); PG8_BAR; PG8_WAIT_L(0); PG8_MMA(0, 0, At, B0); PG8_BAR; PG8_SCHED;
            PG8_LDB(B1, 0, 1); PG8_STAGE(PG8_SB(0, 0), b2, voffB);
            PG8_BAR; PG8_WAIT_L(0); PG8_MMA(0, 1, At, B1); PG8_BAR;
            PG8_LDA(At, 0, 1); PG8_STAGE(PG8_SA(0, 0), a2, voffA);
            PG8_BAR; PG8_WAIT_L(0); PG8_MMA(1, 0, At, B0); PG8_BAR; PG8_SCHED;
            PG8_STAGE(PG8_SB(0, 1), b2 + hstep, voffB);
            PG8_WAIT_V(6); PG8_BAR; PG8_MMA(1, 1, At, B1); PG8_BAR;
            PG8_LDB(B0, 1, 0); PG8_SCHED; PG8_LDA(At, 1, 0); PG8_STAGE(PG8_SA(0, 1), a2 + hstep, voffA);
            PG8_WAIT_L(8); PG8_BAR; PG8_WAIT_L(0); PG8_MMA(0, 0, At, B0); PG8_BAR; PG8_SCHED;
            PG8_LDB(B1, 1, 1); PG8_STAGE(PG8_SB(1, 0), b3, voffB);
            PG8_BAR; PG8_WAIT_L(0); PG8_MMA(0, 1, At, B1); PG8_BAR;
            PG8_LDA(At, 1, 1); PG8_STAGE(PG8_SA(1, 0), a3, voffA);
            PG8_BAR; PG8_WAIT_L(0); PG8_MMA(1, 0, At, B0); PG8_BAR; PG8_SCHED;
            PG8_STAGE(PG8_SB(1, 1), b3 + hstep, voffB);
            PG8_WAIT_V(6); PG8_BAR; PG8_MMA(1, 1, At, B1); PG8_BAR;
            }
        }
        if constexpr (ALIGN_EPI) { if (wr == 0) PG8_BAR; }
        if constexpr (!Epi::AFTER_DRAIN) { E(acc, cur, wr, wc, fr, fq); S.done(cur); }
        if (!has_next) break;
        if (E.zero_after(cur))
#pragma unroll
        for (int a = 0; a < 2; ++a)
#pragma unroll
            for (int b = 0; b < 2; ++b)
#pragma unroll
                for (int m = 0; m < 4; ++m)
#pragma unroll
                    for (int n = 0; n < 2; ++n) acc[a][b][m][n] = (f32x4){0.f, 0.f, 0.f, 0.f};
        cur = nxt; cA = nA; cB = nB; ++ui;
        if constexpr (ALIGN_EPI) { if (wr == 1) PG8_BAR; }
    }
    PG8_WAIT_V(0);
    if constexpr (!ALIGN_EPI) { if (wr == 0) PG8_BAR; }
    PG8_BAR;
    if constexpr (Epi::AFTER_DRAIN) { E.fused(acc, cur, wr, wc, fr, fq, lds, wid, lane); S.done(cur); }
#undef PG8_SA
#undef PG8_SB
#undef PG8_STAGE
#undef PG8_LDA
#undef PG8_LDB
#undef PG8_MMA
#undef PG8_WAIT_V
#undef PG8_WAIT_L
#undef PG8_BAR
#undef PG8_SCHED
}
}
#ifndef PG8_SP2
#define PG8_SP2 true
#endif
#ifndef PG8_ALIGN
#define PG8_ALIGN true
#endif

#define LAS __attribute__((address_space(3)))
typedef unsigned char uchar;
typedef unsigned short bf16;
typedef unsigned u32x4 __attribute__((ext_vector_type(4)));
typedef unsigned u32x2 __attribute__((ext_vector_type(2)));
typedef float f32x4 __attribute__((ext_vector_type(4)));
typedef float f32x2 __attribute__((ext_vector_type(2)));
typedef float f32x16 __attribute__((ext_vector_type(16)));
typedef short bf16x8 __attribute__((ext_vector_type(8)));
typedef short s16x4 __attribute__((ext_vector_type(4)));
typedef __bf16 bf16x2_t __attribute__((ext_vector_type(2)));
#define DI __device__ __forceinline__
#define MFMA32(a, b, c) __builtin_amdgcn_mfma_f32_32x32x16_bf16((a), (b), (c), 0, 0, 0)

DI unsigned pk2(float a, float b) { f32x2 v = {a, b}; return __builtin_bit_cast(unsigned, __builtin_convertvector(v, bf16x2_t)); }
DI float bf_lo(unsigned u) { return __uint_as_float(u << 16); }
DI float bf_hi(unsigned u) { return __uint_as_float(u & 0xffff0000u); }
DI u32x4 pack8(f32x4 a, f32x4 b) { u32x4 w; w.x = pk2(a[0], a[1]); w.y = pk2(a[2], a[3]); w.z = pk2(b[0], b[1]); w.w = pk2(b[2], b[3]); return w; }
DI float sigmoidf_(float v) { return __builtin_amdgcn_rcpf(1.0f + __builtin_amdgcn_exp2f(-1.44269504089f * v)); }
DI float wave_sum(float v) {
#pragma unroll
    for (int o = 1; o < 64; o <<= 1) v += __shfl_xor(v, o);
    return v;
}

constexpr int T = 32768, DM = 1024, FF = 2816, SEQ = 4096;
constexpr float NORM_EPS = 1e-6f;
constexpr float LOG2E = 1.44269504089f;
constexpr float QSCALE_MLA = 0.10206207261596577f * 1.44269504089f;
constexpr float QSCALE_SB = 0.125f * 1.44269504089f;
constexpr size_t MiB = 1u << 20;
constexpr size_t WS_FF1IN = 1 * MiB, WS_FF1OUT = 12 * MiB, WS_FF2IN = 18 * MiB, WS_FF2OUT = 29 * MiB, WS_WIN = 35 * MiB, WS_WSBV = 43 * MiB,
                 WS_WQ = 44 * MiB, WS_WKN = 45 * MiB, WS_WV = 45 * MiB + 512 * 1024, WS_WBM = 46 * MiB, WS_WBS = 47 * MiB, WS_WOUT = 48 * MiB,
                 WS_WG = 50 * MiB, WS_WP = 52 * MiB;
constexpr size_t WS_XN = 54 * MiB, WS_H = 118 * MiB, WS_BIG = 246 * MiB;
constexpr size_t WS_KM = WS_XN, WS_MERGED = WS_XN;
constexpr size_t WS_ACT = WS_BIG, WS_CQ = WS_BIG, WS_CKV = WS_BIG + 24 * MiB, WS_OM = WS_BIG, WS_SBQ = WS_BIG + 40 * MiB, WS_SBK = WS_BIG + 72 * MiB,
                 WS_VTS = WS_BIG + 104 * MiB, WS_QM = WS_BIG + 136 * MiB, WS_VTM = WS_BIG + 184 * MiB, WS_KR = WS_BIG + 216 * MiB,
                 WS_TMP = WS_BIG + 72 * MiB, WS_HB2 = WS_BIG + 176 * MiB, WS_PB = WS_BIG + 240 * MiB, WS_END = WS_BIG + 256 * MiB;
constexpr size_t WS_RS = 0;
constexpr int LDS_BYTES = 147456;

struct Params { const float* in[23]; float* out; unsigned char* ws; };

struct Job { int src, K, Nsrc, Ndst, mode, off; unsigned long long dst; int gain, pad; };
constexpr int NJOBS = 15;
__constant__ Job c_jobs[NJOBS] = {
    {4, 1024, 5632, 5632, 1, 0, WS_FF1IN, 3, 0},   {5, 2816, 1024, 1024, 0, 0, WS_FF1OUT, -1, 0}, {18, 1024, 5632, 5632, 1, 0, WS_FF2IN, 17, 0}, {19, 2816, 1024, 1024, 0, 0, WS_FF2OUT, -1, 0},
    {7, 1024, 4256, 3840, 5, 0, WS_WIN, 6, 0},     {7, 1024, 4256, 512, 0, 1696, WS_WSBV, 6, 0}, {9, 384, 768, 768, 0, 0, WS_WQ, 8, 0},         {11, 256, 1024, 512, 6, 0, WS_WKN, 10, 0},
    {11, 256, 1024, 512, 3, 64, WS_WV, 10, 0},     {14, 512, 1024, 1024, 0, 0, WS_WBM, -1, 0},   {15, 512, 1024, 1024, 0, 0, WS_WBS, -1, 0},    {16, 1024, 1024, 1024, 0, 0, WS_WOUT, -1, 0},
    {21, 1024, 1024, 1024, 0, 0, WS_WG, 20, 0},    {22, 256, 1024, 1024, 0, 0, WS_WP, -1, 0},    {0, 0, 0, 0, 0, 0, 0, -1, 0}};
__constant__ float c_invf[16] = {1.0f, 0.5623413251903491f, 0.31622776601683794f, 0.1778279410038923f, 0.1f, 0.05623413251903491f, 0.03162277660168379f, 0.01778279410038923f,
                                 0.01f, 0.005623413251903491f, 0.0031622776601683794f, 0.001778279410038923f, 0.001f, 0.0005623413251903491f, 0.00031622776601683794f, 0.0001778279410038923f};

DI int map_col(int mode, int n0, int off) {
    if (mode == 0) return n0 + off;
    if (mode == 1) { const int pn = n0 >> 8, half = (n0 >> 7) & 1, j = n0 & 127; return half * FF + pn * 128 + j; }
    if (mode == 2) { const int h = n0 >> 7, j = n0 & 127; return j < 96 ? h * 96 + j : -1; }
    if (mode == 3) { const int h = n0 >> 6, j = n0 & 63; return h * 128 + j + off; }
    if (mode == 6) { const int pn = n0 >> 8, bj = (n0 >> 7) & 1, wc = (n0 >> 5) & 3; return 128 * (4 * pn + wc) + 32 * bj; }
    if (n0 < 672) return n0;
    if (n0 < 768) return -1;
    if (n0 < 1792) return n0 - 96;
    { const int g = n0 - 1792, gt = g >> 8, bj = (g >> 7) & 1; return 2208 + bj * 1024 + gt * 128 + (g & 127); }
}

struct TItem { const float* W; const float* gain; bf16* WT; int K, Nsrc, n0, sc, k0; };
DI void titem_decode(const Params& P, int it, TItem& t) {
    int r = it, j = 0;
    for (; j < NJOBS - 1; ++j) { const int n = (c_jobs[j].K >> 6) * (c_jobs[j].Ndst >> 5); if (r < n) break; r -= n; }
    const int nblk = c_jobs[j].Ndst >> 5, kb = r / nblk, nb = r % nblk;
    t.K = c_jobs[j].K; t.Nsrc = c_jobs[j].Nsrc; t.n0 = nb * 32; t.k0 = kb * 64; t.sc = map_col(c_jobs[j].mode, t.n0, c_jobs[j].off);
    t.W = P.in[c_jobs[j].src]; const int gi = c_jobs[j].gain; t.gain = gi >= 0 ? P.in[gi] : nullptr; t.WT = (bf16*)(P.ws + c_jobs[j].dst);
}
DI void titem_load(const TItem& t, f32x4 (&v)[8], float (&g)[8], int lane) {
#pragma unroll
    for (int i = 0; i < 8; ++i) { const int kk = (lane >> 3) + 8 * i;
        v[i] = (t.sc >= 0) ? *(const f32x4*)(t.W + (size_t)(t.k0 + kk) * t.Nsrc + t.sc + 4 * (lane & 7)) : (f32x4){0.f, 0.f, 0.f, 0.f};
        g[i] = t.gain ? t.gain[t.k0 + kk] : 1.0f; }
}
DI void titem_finish(const TItem& t, const f32x4 (&v)[8], const float (&g)[8], LAS float* scr, int lane) {
#pragma unroll
    for (int i = 0; i < 8; ++i) { const int kk = (lane >> 3) + 8 * i; LAS float* s = scr + kk * 33 + 4 * (lane & 7);
        s[0] = v[i][0] * g[i]; s[1] = v[i][1] * g[i]; s[2] = v[i][2] * g[i]; s[3] = v[i][3] * g[i]; }
    asm volatile("s_waitcnt lgkmcnt(0)" ::: "memory");
    const int c = lane & 7;
#pragma unroll
    for (int j = 0; j < 4; ++j) { const int n = (lane >> 3) + 8 * j; const LAS float* s = scr + (8 * c) * 33 + n;
        u32x4 o; o.x = pk2(s[0 * 33], s[1 * 33]); o.y = pk2(s[2 * 33], s[3 * 33]); o.z = pk2(s[4 * 33], s[5 * 33]); o.w = pk2(s[6 * 33], s[7 * 33]);
        *(u32x4*)(t.WT + (size_t)(t.n0 + n) * t.K + t.k0 + 8 * c) = o; }
    asm volatile("s_waitcnt lgkmcnt(0)" ::: "memory");
}
DI void prep_weights(const Params& P, LAS uchar* lds, int gw, int NGW, int wave, int lane) {
    LAS float* scr = (LAS float*)(lds + wave * 16384);
    int total = 0;
    for (int j = 0; j < NJOBS - 1; ++j) total += (c_jobs[j].K >> 6) * (c_jobs[j].Ndst >> 5);
    if (gw >= total) return;
    TItem cur, nxt; f32x4 va[8], vb[8]; float ga[8], gb[8];
    titem_decode(P, gw, cur); titem_load(cur, va, ga, lane);
    for (int it = gw; it < total; it += 2 * NGW) {
        const bool h1 = it + NGW < total, h2 = it + 2 * NGW < total;
        if (h1) { titem_decode(P, it + NGW, nxt); titem_load(nxt, vb, gb, lane); }
        titem_finish(cur, va, ga, scr, lane);
        if (h2) { titem_decode(P, it + 2 * NGW, cur); titem_load(cur, va, ga, lane); }
        if (h1) titem_finish(nxt, vb, gb, scr, lane);
    }
}

DI void rms_row_1024(const float* xrow, const float* gain, bf16* orow, int lane) {
    const f32x4* xr = (const f32x4*)xrow + lane;
    f32x4 v[4]; float s = 0.f;
#pragma unroll
    for (int j = 0; j < 4; ++j) { v[j] = xr[64 * j]; s += (v[j].x * v[j].x + v[j].y * v[j].y) + (v[j].z * v[j].z + v[j].w * v[j].w); }
    const float r = 1.0f / sqrtf(wave_sum(s) * (1.f / 1024.f) + NORM_EPS);
    u32x2* o8 = (u32x2*)orow + lane;
#pragma unroll
    for (int j = 0; j < 4; ++j) { const f32x4 g = ((const f32x4*)gain)[64 * j + lane]; u32x2 w; w.x = pk2((v[j].x * r) * g.x, (v[j].y * r) * g.y); w.y = pk2((v[j].z * r) * g.z, (v[j].w * r) * g.w); o8[64 * j] = w; }
}
DI void norm_phase(const float* X, const float* gain, bf16* O, int gw, int NGW, int lane) {
    for (int m = gw; m < T; m += NGW) rms_row_1024(X + (size_t)m * DM, gain, O + (size_t)m * DM, lane);
}
template <int NJ> DI void latent_norm_phase(bf16* X, const float* gain, int gw, int NGW, int lane) {
    for (int m = gw; m < T; m += NGW) {
        unsigned* row = (unsigned*)(X + (size_t)m * (128 * NJ)) + lane;
        unsigned u[NJ]; float s = 0.f;
#pragma unroll
        for (int j = 0; j < NJ; ++j) { u[j] = row[64 * j]; const float a = bf_lo(u[j]), b = bf_hi(u[j]); s += a * a + b * b; }
        const float r = 1.0f / sqrtf(wave_sum(s) * (1.f / (128.f * NJ)) + NORM_EPS);
#pragma unroll
        for (int j = 0; j < NJ; ++j) { const f32x2 g = ((const f32x2*)gain)[64 * j + lane]; row[64 * j] = pk2((bf_lo(u[j]) * r) * g.x, (bf_hi(u[j]) * r) * g.y); }
    }
}
DI void x_phase(const float* X, bf16* O, float* RS, int gw, int NGW, int lane) {
    for (int m = gw; m < T; m += 4 * NGW) {
        f32x4 v[4][4];
#pragma unroll
        for (int q = 0; q < 4; ++q) { const int mq = (m + q * NGW < T) ? m + q * NGW : m; const f32x4* xr = (const f32x4*)(X + (size_t)mq * DM) + lane;
#pragma unroll
            for (int j = 0; j < 4; ++j) v[q][j] = xr[64 * j]; }
#pragma unroll
        for (int q = 0; q < 4; ++q) { const int mq = m + q * NGW;
            if (mq < T) { float s = 0.f;
#pragma unroll
                for (int j = 0; j < 4; ++j) s += (v[q][j].x * v[q][j].x + v[q][j].y * v[q][j].y) + (v[q][j].z * v[q][j].z + v[q][j].w * v[q][j].w);
                s = wave_sum(s);
                u32x2* o = (u32x2*)(O + (size_t)mq * DM) + lane;
#pragma unroll
                for (int j = 0; j < 4; ++j) { u32x2 w; w.x = pk2(v[q][j].x, v[q][j].y); w.y = pk2(v[q][j].z, v[q][j].w); o[64 * j] = w; }
                if (lane == 0) RS[mq] = s; } }
    }
}
DI void cvt_phase(const float* X, bf16* O, size_t n8, size_t gtid, size_t NT) {
    for (size_t i = gtid; i < n8; i += 4 * NT) {
        f32x4 a[4], b[4];
#pragma unroll
        for (int q = 0; q < 4; ++q) { const size_t iq = (i + q * NT < n8) ? i + q * NT : i; a[q] = ((const f32x4*)X)[2 * iq]; b[q] = ((const f32x4*)X)[2 * iq + 1]; }
#pragma unroll
        for (int q = 0; q < 4; ++q) if (i + q * NT < n8) ((u32x4*)O)[i + q * NT] = pack8(a[q], b[q]);
    }
}

DI void qk_phase(bf16* Qm, bf16* Km, const float* KR, const int* positions, const float* gq, const float* gk, int gtid, int NT) {
    for (int it = gtid; it < 2 * T * 8; it += NT) {
        const bool isk = it >= T * 8; const int e = isk ? it - T * 8 : it; const int t = e >> 3;
        bf16* base = (isk ? Km : Qm) + (size_t)e * 96;
        float v[96];
#pragma unroll
        for (int c = 0; c < 8; ++c) { const u32x4 w = ((const u32x4*)base)[c];
            v[8 * c + 0] = bf_lo(w.x); v[8 * c + 1] = bf_hi(w.x); v[8 * c + 2] = bf_lo(w.y); v[8 * c + 3] = bf_hi(w.y); v[8 * c + 4] = bf_lo(w.z); v[8 * c + 5] = bf_hi(w.z); v[8 * c + 6] = bf_lo(w.w); v[8 * c + 7] = bf_hi(w.w); }
        if (isk) {
#pragma unroll
            for (int c = 0; c < 8; ++c) { const f32x4 w = ((const f32x4*)(KR + (size_t)t * 32))[c]; v[64 + 4 * c] = w.x; v[65 + 4 * c] = w.y; v[66 + 4 * c] = w.z; v[67 + 4 * c] = w.w; }
        } else {
#pragma unroll
            for (int c = 8; c < 12; ++c) { const u32x4 w = ((const u32x4*)base)[c];
                v[8 * c + 0] = bf_lo(w.x); v[8 * c + 1] = bf_hi(w.x); v[8 * c + 2] = bf_lo(w.y); v[8 * c + 3] = bf_hi(w.y); v[8 * c + 4] = bf_lo(w.z); v[8 * c + 5] = bf_hi(w.z); v[8 * c + 6] = bf_lo(w.w); v[8 * c + 7] = bf_hi(w.w); }
        }
        float ss = 0.f;
#pragma unroll
        for (int d = 0; d < 96; ++d) ss += v[d] * v[d];
        const float r = 1.0f / sqrtf(ss * (1.f / 96.f) + NORM_EPS);
        const float* g = isk ? gk : gq;
#pragma unroll
        for (int d = 0; d < 96; ++d) v[d] = (v[d] * r) * g[d];
        const float posf = (float)positions[t];
#pragma unroll
        for (int i = 0; i < 16; ++i) {
            const float ang = posf * c_invf[i];
            const double rev = (double)ang * 0.15915494309189535;
            const float fr = (float)(rev - rint(rev));
            const float cs = __builtin_amdgcn_cosf(fr), sn = __builtin_amdgcn_sinf(fr);
            const float x1 = v[64 + i], x2 = v[80 + i];
            v[64 + i] = x1 * cs - x2 * sn; v[80 + i] = x2 * cs + x1 * sn;
        }
        const float sc = isk ? 1.0f : QSCALE_MLA;
#pragma unroll
        for (int c = 0; c < 12; ++c) { u32x4 w; w.x = pk2(v[8 * c] * sc, v[8 * c + 1] * sc); w.y = pk2(v[8 * c + 2] * sc, v[8 * c + 3] * sc); w.z = pk2(v[8 * c + 4] * sc, v[8 * c + 5] * sc); w.w = pk2(v[8 * c + 6] * sc, v[8 * c + 7] * sc);
            ((u32x4*)base)[c] = w; }
    }
}

enum { M_SWIGLU = 0, M_RESID, M_INPROJ, M_QUP, M_KNOPE, M_VT, M_DUAL, M_SIGM, M_FINAL, M_RESID_FP, M_RESID_PP };
DI float sq8(const f32x4& a, const f32x4& b) { return (a[0] * a[0] + a[1] * a[1]) + (a[2] * a[2] + a[3] * a[3]) + (b[0] * b[0] + b[1] * b[1]) + (b[2] * b[2] + b[3] * b[3]); }
DI float quad_sum(float v) { v += __shfl_xor(v, 16); v += __shfl_xor(v, 32); return v; }
template <int MODE> struct Epi {
    static constexpr bool PERM = true, AFTER_DRAIN = false;
    void* o0; void* o1; void* o2; void* o3; void* o4; void* o5; const void* i0; const void* i1; float alpha;
    const float* rs; float rsn; float* rso; float* rso2; bf16* hb;
    const int* pos; const float* g2; const float* rs2;
    __device__ __forceinline__ bool zero_after(const pg8::Unit& u) const { if constexpr (MODE == M_DUAL) return u.half != 0; else return true; }
    __device__ __forceinline__ void operator()(pg8::f32x4 (&acc)[2][2][4][2], const pg8::Unit& u, int wr, int wc, int fr, int fq) const {
        const int rowb = u.pm * 256 + wr * 64 + fr;
        const int colb = u.pn * 256 + wc * 32 + 8 * fq;
        if constexpr (MODE == M_SWIGLU || MODE == M_INPROJ || MODE == M_QUP || MODE == M_SIGM) {
            float rsc[2][4];
#pragma unroll
            for (int ai = 0; ai < 2; ++ai)
#pragma unroll
                for (int m = 0; m < 4; ++m) rsc[ai][m] = rs[rowb + ai * 128 + m * 16];
#pragma unroll
            for (int ai = 0; ai < 2; ++ai)
#pragma unroll
                for (int m = 0; m < 4; ++m) rsc[ai][m] = __builtin_amdgcn_rsqf(rsc[ai][m] * rsn + NORM_EPS);
            if constexpr (MODE == M_SWIGLU) {
                const int col = u.pn * 128 + wc * 32 + 8 * fq;
#pragma unroll
                for (int ai = 0; ai < 2; ++ai)
#pragma unroll
                    for (int m = 0; m < 4; ++m) {
                        const float r = rsc[ai][m];
                        f32x4 a0 = acc[ai][0][m][0], a1 = acc[ai][0][m][1]; const f32x4 b0 = acc[ai][1][m][0], b1 = acc[ai][1][m][1];
#pragma unroll
                        for (int i = 0; i < 4; ++i) { const float x0 = a0[i] * r, x1 = a1[i] * r; a0[i] = x0 * sigmoidf_(x0) * (b0[i] * r); a1[i] = x1 * sigmoidf_(x1) * (b1[i] * r); }
                        *(u32x4*)((bf16*)o0 + (size_t)(rowb + ai * 128 + m * 16) * FF + col) = pack8(a0, a1);
                    }
            } else if constexpr (MODE == M_QUP) {
#pragma unroll
                for (int ai = 0; ai < 2; ++ai)
#pragma unroll
                    for (int m = 0; m < 4; ++m)
#pragma unroll
                        for (int bj = 0; bj < 2; ++bj)
                            *(u32x4*)((bf16*)o0 + (size_t)(rowb + ai * 128 + m * 16) * 768 + colb + bj * 128) = pack8(acc[ai][bj][m][0] * rsc[ai][m], acc[ai][bj][m][1] * rsc[ai][m]);
            } else if constexpr (MODE == M_SIGM) {
#pragma unroll
                for (int ai = 0; ai < 2; ++ai)
#pragma unroll
                    for (int m = 0; m < 4; ++m)
#pragma unroll
                        for (int bj = 0; bj < 2; ++bj) {
                            f32x4 v0 = acc[ai][bj][m][0] * rsc[ai][m], v1 = acc[ai][bj][m][1] * rsc[ai][m];
#pragma unroll
                            for (int i = 0; i < 4; ++i) { v0[i] = sigmoidf_(v0[i]); v1[i] = sigmoidf_(v1[i]); }
                            *(u32x4*)((bf16*)o0 + (size_t)(rowb + ai * 128 + m * 16) * DM + colb + bj * 128) = pack8(v0, v1);
                        }
            } else if (u.pn >= 7) {
                const int gcol = (u.pn - 7) * 128 + wc * 32 + 8 * fq;
#pragma unroll
                for (int ai = 0; ai < 2; ++ai)
#pragma unroll
                    for (int m = 0; m < 4; ++m) {
                        const int row = rowb + ai * 128 + m * 16; const float r = rsc[ai][m];
                        f32x4 a0 = acc[ai][0][m][0] * r, a1 = acc[ai][0][m][1] * r, b0 = acc[ai][1][m][0] * r, b1 = acc[ai][1][m][1] * r;
#pragma unroll
                        for (int i = 0; i < 4; ++i) { b0[i] = fmaxf(sigmoidf_(b0[i]), 1e-18f); b1[i] = fmaxf(sigmoidf_(b1[i]), 1e-18f);
                            a0[i] = sigmoidf_(a0[i]) * __builtin_amdgcn_rcpf(b0[i]); a1[i] = sigmoidf_(a1[i]) * __builtin_amdgcn_rcpf(b1[i]); }
                        bf16* gp = (bf16*)o5 + (size_t)row * 2048 + gcol;
                        *(u32x4*)gp = pack8(a0, a1); *(u32x4*)(gp + 1024) = pack8(b0, b1);
                    }
            } else {
#pragma unroll
                for (int ai = 0; ai < 2; ++ai)
#pragma unroll
                    for (int m = 0; m < 4; ++m) {
                        const int row = rowb + ai * 128 + m * 16; const float r = rsc[ai][m];
                        float ssq = 0.f, ssq2 = 0.f;
#pragma unroll
                        for (int bj = 0; bj < 2; ++bj) {
                            const int col0 = colb + bj * 128;
                            f32x4 v0 = acc[ai][bj][m][0] * r, v1 = acc[ai][bj][m][1] * r;
                            if (col0 < 384) { *(u32x4*)((bf16*)o0 + (size_t)row * 384 + col0) = pack8(v0, v1); ssq += sq8(v0, v1); }
                            else if (col0 < 640) { *(u32x4*)((bf16*)o1 + (size_t)row * 256 + (col0 - 384)) = pack8(v0, v1); ssq2 += sq8(v0, v1); }
                            else if (col0 < 672) {
                                const float sk = quad_sum(sq8(v0, v1));
                                if (fq == 0) rso[2 * T + row] = sk;
                                const int c0 = col0 - 640;
                                const f32x4 ga = *(const f32x4*)(g2 + 64 + c0), gb = *(const f32x4*)(g2 + 64 + c0 + 4);
                                v0 = v0 * ga; v1 = v1 * gb;
                                const float posf = (float)pos[row];
                                float xv[8] = {v0[0], v0[1], v0[2], v0[3], v1[0], v1[1], v1[2], v1[3]};
                                const int ib = (fq & 1) * 8; const bool second = fq >= 2;
#pragma unroll
                                for (int j = 0; j < 8; ++j) {
                                    const float other = __shfl_xor(xv[j], 32);
                                    const float ang = posf * c_invf[ib + j];
                                    const double rev = (double)ang * 0.15915494309189535;
                                    const float frc = (float)(rev - rint(rev));
                                    const float cs = __builtin_amdgcn_cosf(frc), sn = __builtin_amdgcn_sinf(frc);
                                    xv[j] = second ? (xv[j] * cs + other * sn) : (xv[j] * cs - other * sn);
                                }
                                float* kr = (float*)o2 + (size_t)row * 32 + c0;
                                *(f32x4*)kr = (f32x4){xv[0], xv[1], xv[2], xv[3]}; *(f32x4*)(kr + 4) = (f32x4){xv[4], xv[5], xv[6], xv[7]};
                            }
                            else if (col0 < 768) { }
                            else if (col0 < 1280) { *(u32x4*)((bf16*)o3 + (size_t)row * 512 + (col0 - 768)) = pack8(v0 * QSCALE_SB, v1 * QSCALE_SB); }
                            else if (col0 < 1792) { *(u32x4*)((bf16*)o4 + (size_t)row * 512 + (col0 - 1280)) = pack8(v0, v1); }
                            else { }
                        }
                        if (u.pn < 3) {
                            ssq = quad_sum(ssq); ssq2 = quad_sum(ssq2);
                            if (fq == 0) { if (u.pn < 2) unsafeAtomicAdd(rso + row, ssq); if (u.pn > 0) unsafeAtomicAdd(rso + T + row, ssq2); }
                        }
                    }
            }
        } else if constexpr (MODE == M_RESID || MODE == M_RESID_FP || MODE == M_RESID_PP) {
            constexpr int MB = (MODE == M_RESID_FP) ? 4 : 2;
#pragma unroll
            for (int ai = 0; ai < 2; ++ai)
#pragma unroll
            for (int mb = 0; mb < 4; mb += MB) {
                f32x4 pre[MB][2][2];
                if constexpr (MODE == M_RESID_FP) {
#pragma unroll
                    for (int m = 0; m < MB; ++m)
#pragma unroll
                        for (int bj = 0; bj < 2; ++bj) { const float* bp = (const float*)i0 + (size_t)(rowb + ai * 128 + (mb + m) * 16) * DM + colb + bj * 128; pre[m][bj][0] = *(const f32x4*)bp; pre[m][bj][1] = *(const f32x4*)(bp + 4); }
                } else {
                    u32x4 ph[MB][2], pl[MB][2];
#pragma unroll
                    for (int m = 0; m < MB; ++m)
#pragma unroll
                        for (int bj = 0; bj < 2; ++bj) { const size_t off = (size_t)(rowb + ai * 128 + (mb + m) * 16) * DM + colb + bj * 128; ph[m][bj] = *(const u32x4*)((const bf16*)i0 + off); pl[m][bj] = *(const u32x4*)((const bf16*)i1 + off); }
#pragma unroll
                    for (int m = 0; m < MB; ++m)
#pragma unroll
                        for (int bj = 0; bj < 2; ++bj) { const u32x4 a = ph[m][bj], b = pl[m][bj];
                            pre[m][bj][0] = (f32x4){bf_lo(a.x) + bf_lo(b.x), bf_hi(a.x) + bf_hi(b.x), bf_lo(a.y) + bf_lo(b.y), bf_hi(a.y) + bf_hi(b.y)};
                            pre[m][bj][1] = (f32x4){bf_lo(a.z) + bf_lo(b.z), bf_hi(a.z) + bf_hi(b.z), bf_lo(a.w) + bf_lo(b.w), bf_hi(a.w) + bf_hi(b.w)}; }
                }
#pragma unroll
                for (int m = 0; m < MB; ++m) {
                    const int row = rowb + ai * 128 + (mb + m) * 16; float ssq = 0.f;
#pragma unroll
                    for (int bj = 0; bj < 2; ++bj) {
                        const size_t off = (size_t)row * DM + colb + bj * 128;
                        const f32x4 r0 = pre[m][bj][0] + acc[ai][bj][mb + m][0] * alpha, r1 = pre[m][bj][1] + acc[ai][bj][mb + m][1] * alpha;
                        const u32x4 hi = pack8(r0, r1);
                        if constexpr (MODE == M_RESID) { *(f32x4*)((float*)o0 + off) = r0; *(f32x4*)((float*)o0 + off + 4) = r1; *(u32x4*)(hb + off) = hi; }
                        else {
                            const f32x4 d0 = {r0[0] - bf_lo(hi.x), r0[1] - bf_hi(hi.x), r0[2] - bf_lo(hi.y), r0[3] - bf_hi(hi.y)}, d1 = {r1[0] - bf_lo(hi.z), r1[1] - bf_hi(hi.z), r1[2] - bf_lo(hi.w), r1[3] - bf_hi(hi.w)};
                            *(u32x4*)((bf16*)o0 + off) = hi; *(u32x4*)((bf16*)o1 + off) = pack8(d0, d1);
                        }
                        ssq += sq8(r0, r1);
                    }
                    ssq = quad_sum(ssq);
                    if (fq == 0) unsafeAtomicAdd(rso + row, ssq);
                }
            }
        } else if constexpr (MODE == M_KNOPE) {
            const int hd = u.pn * 4 + wc;
#pragma unroll
            for (int ai = 0; ai < 2; ++ai) {
                float rkv[4], rkr[4]; f32x4 krr[4][2];
#pragma unroll
                for (int m = 0; m < 4; ++m) { const int row = rowb + ai * 128 + m * 16; rkv[m] = rs[row]; rkr[m] = rs2[row]; const float* kp = (const float*)i0 + (size_t)row * 32 + 8 * fq; krr[m][0] = *(const f32x4*)kp; krr[m][1] = *(const f32x4*)(kp + 4); }
                const f32x4 g00 = *(const f32x4*)(g2 + 8 * fq), g01 = *(const f32x4*)(g2 + 8 * fq + 4), g10 = *(const f32x4*)(g2 + 32 + 8 * fq), g11 = *(const f32x4*)(g2 + 32 + 8 * fq + 4);
#pragma unroll
                for (int m = 0; m < 4; ++m) {
                    const int row = rowb + ai * 128 + m * 16;
                    const float r = __builtin_amdgcn_rsqf(rkv[m] * rsn + NORM_EPS);
                    f32x4 a0 = acc[ai][0][m][0] * r, a1 = acc[ai][0][m][1] * r, b0 = acc[ai][1][m][0] * r, b1 = acc[ai][1][m][1] * r;
                    const float ss = quad_sum(sq8(a0, a1) + sq8(b0, b1)) + rkr[m];
                    const float rk = __builtin_amdgcn_rsqf(ss * (1.f / 96.f) + NORM_EPS);
                    bf16* kp = (bf16*)o0 + (size_t)row * 768 + hd * 96 + 8 * fq;
                    *(u32x4*)kp = pack8((a0 * rk) * g00, (a1 * rk) * g01);
                    *(u32x4*)(kp + 32) = pack8((b0 * rk) * g10, (b1 * rk) * g11);
                    *(u32x4*)(kp + 64) = pack8(krr[m][0] * rk, krr[m][1] * rk);
                }
            }
        } else if constexpr (MODE == M_VT) {
            f32x4 sc[2][2];
#pragma unroll
            for (int bj = 0; bj < 2; ++bj) { sc[bj][0] = *(const f32x4*)(rs + colb + bj * 128); sc[bj][1] = *(const f32x4*)(rs + colb + bj * 128 + 4); }
#pragma unroll
            for (int bj = 0; bj < 2; ++bj)
#pragma unroll
                for (int i = 0; i < 4; ++i) { sc[bj][0][i] = __builtin_amdgcn_rsqf(sc[bj][0][i] * rsn + NORM_EPS); sc[bj][1][i] = __builtin_amdgcn_rsqf(sc[bj][1][i] * rsn + NORM_EPS); }
#pragma unroll
            for (int ai = 0; ai < 2; ++ai)
#pragma unroll
                for (int m = 0; m < 4; ++m)
#pragma unroll
                    for (int bj = 0; bj < 2; ++bj) { const int col0 = colb + bj * 128;
                        *(u32x4*)((bf16*)o0 + (size_t)(col0 >> 12) * (512 * 4096) + (size_t)(rowb + ai * 128 + m * 16) * 4096 + (col0 & 4095)) = pack8(acc[ai][bj][m][0] * sc[bj][0], acc[ai][bj][m][1] * sc[bj][1]); }
        } else if constexpr (MODE == M_DUAL) {
            const bf16* G = (const bf16*)i0;
            if (u.half == 0) {
                u32x4 ga[2][4][2];
#pragma unroll
                for (int ai = 0; ai < 2; ++ai)
#pragma unroll
                    for (int m = 0; m < 4; ++m)
#pragma unroll
                        for (int bj = 0; bj < 2; ++bj) ga[ai][m][bj] = *(const u32x4*)(G + (size_t)(rowb + ai * 128 + m * 16) * 2048 + colb + bj * 128);
#pragma unroll
                for (int ai = 0; ai < 2; ++ai)
#pragma unroll
                    for (int m = 0; m < 4; ++m)
#pragma unroll
                        for (int bj = 0; bj < 2; ++bj) {
                            const u32x4 a = ga[ai][m][bj];
                            acc[ai][bj][m][0][0] *= bf_lo(a.x); acc[ai][bj][m][0][1] *= bf_hi(a.x); acc[ai][bj][m][0][2] *= bf_lo(a.y); acc[ai][bj][m][0][3] *= bf_hi(a.y);
                            acc[ai][bj][m][1][0] *= bf_lo(a.z); acc[ai][bj][m][1][1] *= bf_hi(a.z); acc[ai][bj][m][1][2] *= bf_lo(a.w); acc[ai][bj][m][1][3] *= bf_hi(a.w);
                        }
            } else {
                u32x4 gb[2][4][2];
#pragma unroll
                for (int ai = 0; ai < 2; ++ai)
#pragma unroll
                    for (int m = 0; m < 4; ++m)
#pragma unroll
                        for (int bj = 0; bj < 2; ++bj) gb[ai][m][bj] = *(const u32x4*)(G + (size_t)(rowb + ai * 128 + m * 16) * 2048 + 1024 + colb + bj * 128);
#pragma unroll
                for (int ai = 0; ai < 2; ++ai)
#pragma unroll
                    for (int m = 0; m < 4; ++m)
#pragma unroll
                        for (int bj = 0; bj < 2; ++bj) {
                            const u32x4 b = gb[ai][m][bj]; f32x4 v0 = acc[ai][bj][m][0], v1 = acc[ai][bj][m][1];
                            v0[0] *= bf_lo(b.x); v0[1] *= bf_hi(b.x); v0[2] *= bf_lo(b.y); v0[3] *= bf_hi(b.y); v1[0] *= bf_lo(b.z); v1[1] *= bf_hi(b.z); v1[2] *= bf_lo(b.w); v1[3] *= bf_hi(b.w);
                            *(u32x4*)((bf16*)o0 + (size_t)(rowb + ai * 128 + m * 16) * DM + colb + bj * 128) = pack8(v0, v1);
                        }
            }
        } else if constexpr (MODE == M_FINAL) {
#pragma unroll
            for (int ai = 0; ai < 2; ++ai)
#pragma unroll
            for (int mh = 0; mh < 2; ++mh) {
                u32x4 ph[2][2], pl[2][2], gt[2][2];
#pragma unroll
                for (int m = 0; m < 2; ++m)
#pragma unroll
                    for (int bj = 0; bj < 2; ++bj) { const size_t off = (size_t)(rowb + ai * 128 + (mh * 2 + m) * 16) * DM + colb + bj * 128;
                        ph[m][bj] = *(const u32x4*)((const bf16*)i0 + off); pl[m][bj] = *(const u32x4*)((const bf16*)o1 + off); gt[m][bj] = *(const u32x4*)((const bf16*)i1 + off); }
#pragma unroll
                for (int m = 0; m < 2; ++m)
#pragma unroll
                    for (int bj = 0; bj < 2; ++bj) { const size_t off = (size_t)(rowb + ai * 128 + (mh * 2 + m) * 16) * DM + colb + bj * 128;
                        const u32x4 g = gt[m][bj], a = ph[m][bj], b = pl[m][bj]; const f32x4 v0 = acc[ai][bj][mh * 2 + m][0], v1 = acc[ai][bj][mh * 2 + m][1]; f32x4 r0, r1;
                        r0[0] = (bf_lo(a.x) + bf_lo(b.x)) + bf_lo(g.x) * v0[0]; r0[1] = (bf_hi(a.x) + bf_hi(b.x)) + bf_hi(g.x) * v0[1]; r0[2] = (bf_lo(a.y) + bf_lo(b.y)) + bf_lo(g.y) * v0[2]; r0[3] = (bf_hi(a.y) + bf_hi(b.y)) + bf_hi(g.y) * v0[3];
                        r1[0] = (bf_lo(a.z) + bf_lo(b.z)) + bf_lo(g.z) * v1[0]; r1[1] = (bf_hi(a.z) + bf_hi(b.z)) + bf_hi(g.z) * v1[1]; r1[2] = (bf_lo(a.w) + bf_lo(b.w)) + bf_lo(g.w) * v1[2]; r1[3] = (bf_hi(a.w) + bf_hi(b.w)) + bf_hi(g.w) * v1[3];
                        *(f32x4*)((float*)o0 + off) = r0; *(f32x4*)((float*)o0 + off + 4) = r1; }
            }
        }
    }
};
struct DualOrder {
    pg8::StaticOrder S;
    __device__ bool next(int i, pg8::Unit& u) const { const bool ok = S.next(i >> 1, u); u.half = i & 1; return ok; }
    __device__ __forceinline__ void a_ready(const pg8::Unit&) const {}
    __device__ __forceinline__ void done(const pg8::Unit&) const {}
};
template <int MODE> DI void run_gemm(LAS uchar* lds, const bf16* A, const bf16* Bt, int M, int N, int K, const Epi<MODE>& E, int wave_s) {
    asm volatile("" : "+s"(M), "+s"(N), "+s"(K));
    pg8::Gemm g{A, Bt, M, N, K, nullptr, nullptr}; pg8::StaticOrder S; S.init(M, N, (int)gridDim.x, (int)blockIdx.x);
    pg8::gemm_phase<Epi<MODE>, pg8::StaticOrder, PG8_ALIGN, PG8_SP2>(lds, g, S, E, wave_s);
}
DI void run_gemm_dual(LAS uchar* lds, const bf16* A, const bf16* Bt, const bf16* A2, const bf16* Bt2, int M, int N, int K, const Epi<M_DUAL>& E, int wave_s) {
    asm volatile("" : "+s"(M), "+s"(N), "+s"(K));
    pg8::Gemm g{A, Bt, M, N, K, A2, Bt2}; DualOrder S; S.S.init(M, N, (int)gridDim.x, (int)blockIdx.x);
    pg8::gemm_phase<Epi<M_DUAL>, DualOrder, PG8_ALIGN, PG8_SP2>(lds, g, S, E, wave_s);
}

DI int crow(int reg, int h) { return (reg & 3) + 8 * (reg >> 2) + 4 * h; }
constexpr int KP_MLA = 208, KP_SB = 144, VP = 144;
constexpr int LDS_K = 0, LDS_V = 16384, LDS_FLAGS = 32768;

constexpr int MLA_BUF = 24576, MLA_VOFF = 13312;
#define LBAR() do { asm volatile("s_waitcnt lgkmcnt(0)" ::: "memory"); __builtin_amdgcn_s_barrier(); asm volatile("" ::: "memory"); } while (0)
constexpr int MLA_SUB = 22528, MLA_BIG = 2 * MLA_SUB;
DI void mla_qk_t(LAS uchar* ldsK, int r, int h, const f32x16& negv, const bf16x8 (&qf)[6], f32x16& s0, f32x16& s1) {
    bf16x8 a0[6], a1[6];
#pragma unroll
    for (int kb = 0; kb < 6; ++kb) { a0[kb] = *(const LAS bf16x8*)(ldsK + r * KP_MLA + (16 * kb + 8 * h) * 2); a1[kb] = *(const LAS bf16x8*)(ldsK + (32 + r) * KP_MLA + (16 * kb + 8 * h) * 2); }
    s0 = MFMA32(a0[0], qf[0], negv); s1 = MFMA32(a1[0], qf[0], negv);
#pragma unroll
    for (int kb = 1; kb < 6; ++kb) { s0 = MFMA32(a0[kb], qf[kb], s0); s1 = MFMA32(a1[kb], qf[kb], s1); }
}
DI void mla_sm_t(f32x16& s0, f32x16& s1, bf16x8 (&P)[4], float& lrun) {
#pragma unroll
    for (int i = 0; i < 16; ++i) { s0[i] = __builtin_amdgcn_exp2f(s0[i]); s1[i] = __builtin_amdgcn_exp2f(s1[i]); }
    float pa[8];
#pragma unroll
    for (int i = 0; i < 8; ++i) pa[i] = (s0[i] + s0[8 + i]) + (s1[i] + s1[8 + i]);
    lrun += ((pa[0] + pa[1]) + (pa[2] + pa[3])) + ((pa[4] + pa[5]) + (pa[6] + pa[7]));
#pragma unroll
    for (int t = 0; t < 2; ++t) {
        u32x4 pa, pb;
        pa.x = pk2(s0[8 * t], s0[8 * t + 1]); pa.y = pk2(s0[8 * t + 2], s0[8 * t + 3]); pa.z = pk2(s0[8 * t + 4], s0[8 * t + 5]); pa.w = pk2(s0[8 * t + 6], s0[8 * t + 7]);
        pb.x = pk2(s1[8 * t], s1[8 * t + 1]); pb.y = pk2(s1[8 * t + 2], s1[8 * t + 3]); pb.z = pk2(s1[8 * t + 4], s1[8 * t + 5]); pb.w = pk2(s1[8 * t + 6], s1[8 * t + 7]);
        P[t] = __builtin_bit_cast(bf16x8, pa); P[2 + t] = __builtin_bit_cast(bf16x8, pb);
    }
}
DI void mla_pv_t(LAS uchar* ldsV, int r, int h, const bf16x8 (&P)[4], f32x16& o0, f32x16& o1) {
#pragma unroll
    for (int q = 0; q < 4; ++q) {
        const int koff = (16 * q + 4 * h) * 2;
        { const s16x4 lo = *(const LAS s16x4*)(ldsV + r * VP + koff), hi = *(const LAS s16x4*)(ldsV + r * VP + koff + 16);
          o0 = MFMA32(__builtin_shufflevector(lo, hi, 0, 1, 2, 3, 4, 5, 6, 7), P[q], o0); }
        { const s16x4 lo = *(const LAS s16x4*)(ldsV + (32 + r) * VP + koff), hi = *(const LAS s16x4*)(ldsV + (32 + r) * VP + koff + 16);
          o1 = MFMA32(__builtin_shufflevector(lo, hi, 0, 1, 2, 3, 4, 5, 6, 7), P[q], o1); }
    }
}
DI void mla_step2(LAS uchar* buf, int J, int jmax, int q0, int r, int h, const f32x16& negv, const bf16x8 (&qf)[6], f32x16& o0, f32x16& o1, float& lrun) {
    const int j0 = 2 * J;
    if (j0 + 1 < jmax) {
        f32x16 sa0, sa1, sb0, sb1; bf16x8 Pa[4], Pb[4];
        mla_qk_t(buf, r, h, negv, qf, sa0, sa1);
        mla_qk_t(buf + MLA_SUB, r, h, negv, qf, sb0, sb1);
        mla_sm_t(sa0, sa1, Pa, lrun);
        mla_pv_t(buf + MLA_VOFF, r, h, Pa, o0, o1);
        mla_sm_t(sb0, sb1, Pb, lrun);
        mla_pv_t(buf + MLA_SUB + MLA_VOFF, r, h, Pb, o0, o1);
        __builtin_amdgcn_sched_group_barrier(0x100, 12, 0); __builtin_amdgcn_sched_group_barrier(0x008, 12, 0);
        __builtin_amdgcn_sched_group_barrier(0x100, 12, 0);
#pragma unroll
        for (int g_ = 0; g_ < 12; ++g_) { __builtin_amdgcn_sched_group_barrier(0x008, 1, 0); __builtin_amdgcn_sched_group_barrier(0x002, 8, 0); }
    } else {
#pragma unroll
        for (int sub = 0; sub < 2; ++sub) {
            const int j = j0 + sub;
            if (j <= jmax) {
                f32x16 s0, s1; bf16x8 P[4];
                mla_qk_t(buf + sub * MLA_SUB, r, h, negv, qf, s0, s1);
                __builtin_amdgcn_sched_group_barrier(0x100, 12, 0); __builtin_amdgcn_sched_group_barrier(0x008, 12, 0);
                if (j == jmax) { const int tq = q0 + r - 64 * j;
#pragma unroll
                    for (int i = 0; i < 16; ++i) { if (crow(i, h) > tq) s0[i] = -INFINITY; if (32 + crow(i, h) > tq) s1[i] = -INFINITY; } }
                mla_sm_t(s0, s1, P, lrun);
                mla_pv_t(buf + sub * MLA_SUB + MLA_VOFF, r, h, P, o0, o1);
            }
        }
    }
}
DI void mla_unit(LAS uchar* lds, const bf16* Qm, const bf16* Km, const bf16* Vt, bf16* O, const int* positions, const float* gq, const float* gk, int bh, int qb, int tid, int wid, int lane) {
    asm volatile("" : "+v"(tid), "+v"(lane));
    asm volatile("" : "+s"(gq), "+s"(gk));
    const int b = bh >> 3, hd = bh & 7, r = lane & 31, h = lane >> 5;
    const size_t tbase = (size_t)b * SEQ;
    const int q0 = qb * 256 + wid * 32;
    const int nt = 4 * (qb + 1), jmax = 4 * qb + (wid >> 1);
    const int NT2 = nt >> 1;
    const char* kg = (const char*)(Km + tbase * 768 + hd * 96);
    const char* vg = (const char*)(Vt + (size_t)bh * 64 * SEQ);
    unsigned dvo[3], dts[3], dlo[3]; const char* dgb[3];
#pragma unroll
    for (int k = 0; k < 3; ++k) { const int q = wid + 8 * k;
        if (q < 13) { const int s = 64 * q + lane, row = s / 13, c = s % 13; dgb[k] = kg; dts[k] = 64u * 1536u; dvo[k] = (unsigned)(row * 1536 + (c < 12 ? c : 11) * 16); dlo[k] = 1024u * q; }
        else { const int i = q - 13, s = 64 * i + lane, row = s / 9, c = s % 9; dgb[k] = vg; dts[k] = 128u; dvo[k] = (unsigned)(row * (SEQ * 2) + (c < 8 ? c : 7) * 16); dlo[k] = MLA_VOFF + 1024u * i; } }
    const bool three = wid < 6;
#define MLA_ISSUE1(jt, off) do { _Pragma("unroll") for (int k_ = 0; k_ < 3; ++k_) if (k_ < 2 || three) \
        __builtin_amdgcn_global_load_lds((const unsigned*)(dgb[k_] + (size_t)(jt) * dts[k_] + dvo[k_]), (LAS unsigned*)(lds + (off) + dlo[k_]), 16, 0, 0); } while (0)
#define MLA_ISSUE2(JJ) do { const int bo_ = ((JJ) % 3) * MLA_BIG; MLA_ISSUE1(2 * (JJ), bo_); MLA_ISSUE1(2 * (JJ) + 1, bo_ + MLA_SUB); } while (0)
    MLA_ISSUE2(0); if (NT2 > 1) MLA_ISSUE2(1);
    __builtin_amdgcn_sched_barrier(0);
    bf16x8 qf[6]; float negm;
    { const bf16* qp = Qm + (tbase + q0 + r) * 768 + hd * 96 + 8 * h;
      float gmax = 0.f;
#pragma unroll
      for (int kb = 0; kb < 6; ++kb) { const f32x4 ka = *(const f32x4*)(gk + 16 * kb + 8 * h), kb4 = *(const f32x4*)(gk + 16 * kb + 8 * h + 4);
#pragma unroll
          for (int j = 0; j < 4; ++j) gmax = fmaxf(gmax, fmaxf(fabsf(ka[j]), fabsf(kb4[j]))); }
      gmax = fmaxf(gmax, __shfl_xor(gmax, 32));
      asm volatile("" : "+v"(gmax));
      float qv[6][8]; float ss = 0.f;
#pragma unroll
      for (int kb = 0; kb < 6; ++kb) { const u32x4 w = *(const u32x4*)(qp + 16 * kb);
          qv[kb][0] = bf_lo(w.x); qv[kb][1] = bf_hi(w.x); qv[kb][2] = bf_lo(w.y); qv[kb][3] = bf_hi(w.y); qv[kb][4] = bf_lo(w.z); qv[kb][5] = bf_hi(w.z); qv[kb][6] = bf_lo(w.w); qv[kb][7] = bf_hi(w.w); }
#pragma unroll
      for (int kb = 0; kb < 6; ++kb)
#pragma unroll
          for (int j = 0; j < 8; ++j) ss += qv[kb][j] * qv[kb][j];
      ss += __shfl_xor(ss, 32);
      const float rq = __builtin_amdgcn_rsqf(ss * (1.f / 96.f) + NORM_EPS);
      float qn2 = 0.f;
#pragma unroll
      for (int kb = 0; kb < 6; ++kb) { const f32x4 ga = *(const f32x4*)(gq + 16 * kb + 8 * h), gb = *(const f32x4*)(gq + 16 * kb + 8 * h + 4);
#pragma unroll
          for (int j = 0; j < 4; ++j) { qv[kb][j] = (qv[kb][j] * rq) * ga[j]; qv[kb][4 + j] = (qv[kb][4 + j] * rq) * gb[j];
              qn2 += qv[kb][j] * qv[kb][j] + qv[kb][4 + j] * qv[kb][4 + j]; } }
      qn2 += __shfl_xor(qn2, 32);
      negm = -(1.02f * QSCALE_MLA * 9.79795897f) * sqrtf(qn2) * gmax;
      const float posf = (float)positions[tbase + q0 + r];
#pragma unroll
      for (int j = 0; j < 8; ++j) {
          const float ang = posf * c_invf[8 * h + j];
          const double rev = (double)ang * 0.15915494309189535;
          const float frc = (float)(rev - rint(rev));
          const float cs = __builtin_amdgcn_cosf(frc), sn = __builtin_amdgcn_sinf(frc);
          const float x1 = qv[4][j], x2 = qv[5][j];
          qv[4][j] = x1 * cs - x2 * sn; qv[5][j] = x2 * cs + x1 * sn;
      }
#pragma unroll
      for (int kb = 0; kb < 6; ++kb) { u32x4 w; w.x = pk2(qv[kb][0] * QSCALE_MLA, qv[kb][1] * QSCALE_MLA); w.y = pk2(qv[kb][2] * QSCALE_MLA, qv[kb][3] * QSCALE_MLA); w.z = pk2(qv[kb][4] * QSCALE_MLA, qv[kb][5] * QSCALE_MLA); w.w = pk2(qv[kb][6] * QSCALE_MLA, qv[kb][7] * QSCALE_MLA);
          qf[kb] = __builtin_bit_cast(bf16x8, w); } }
    f32x16 o0, o1;
#pragma unroll
    for (int i = 0; i < 16; ++i) { o0[i] = 0.f; o1[i] = 0.f; }
    float lrun = 0.f;
    f32x16 negv;
#pragma unroll
    for (int i = 0; i < 16; ++i) negv[i] = negm;
    asm volatile("" : "+v"(negv));
    if (NT2 > 1) { if (three) asm volatile("s_waitcnt vmcnt(6)" ::: "memory"); else asm volatile("s_waitcnt vmcnt(4)" ::: "memory"); } else asm volatile("s_waitcnt vmcnt(0)" ::: "memory");
    LBAR();
    if (wid >= 4) __builtin_amdgcn_s_setprio(1);
    for (int J = 0; J < NT2; ++J) {
        if (J + 2 < NT2) MLA_ISSUE2(J + 2);
        if (2 * J <= jmax) mla_step2(lds + (J % 3) * MLA_BIG, J, jmax, q0, r, h, negv, qf, o0, o1, lrun);
        if (J + 2 < NT2) { if (three) asm volatile("s_waitcnt vmcnt(6)" ::: "memory"); else asm volatile("s_waitcnt vmcnt(4)" ::: "memory"); }
        else asm volatile("s_waitcnt vmcnt(0)" ::: "memory");
        LBAR();
    }
    __builtin_amdgcn_s_setprio(0);
#undef MLA_ISSUE1
#undef MLA_ISSUE2
#define MLA_STEP 0
#undef MLA_STEP
#undef MLA_LOAD
#undef MLA_STORE
    lrun += __shfl_xor(lrun, 32);
    const float inv = 1.0f / lrun;
    bf16* op = O + (tbase + q0 + r) * 512 + hd * 64 + 4 * h;
#pragma unroll
    for (int g = 0; g < 4; ++g) {
        u32x2 w0, w1; w0.x = pk2(o0[4 * g] * inv, o0[4 * g + 1] * inv); w0.y = pk2(o0[4 * g + 2] * inv, o0[4 * g + 3] * inv);
        w1.x = pk2(o1[4 * g] * inv, o1[4 * g + 1] * inv); w1.y = pk2(o1[4 * g + 2] * inv, o1[4 * g + 3] * inv);
        *(u32x2*)(op + 8 * g) = w0; *(u32x2*)(op + 32 + 8 * g) = w1;
    }
}

DI void sb_subtile(f32x16& z, bool diag, int tq, int koffs, int h, float& carry) {
    float R[16];
#pragma unroll
    for (int i = 0; i < 16; ++i) { const bool msk = diag && (koffs + crow(i, h) >= tq); const float E = __builtin_amdgcn_exp2f(fminf(z[i], 100.f)); const float rr = __builtin_amdgcn_rcpf(1.0f + E);
        R[i] = msk ? 1.0f : rr; z[i] = msk ? 0.f : E * rr; }
    float G[4], PG[4];
#pragma unroll
    for (int g = 0; g < 4; ++g) { G[g] = (R[4 * g] * R[4 * g + 1]) * (R[4 * g + 2] * R[4 * g + 3]); PG[g] = __shfl_xor(G[g], 32); }
    float Rr = carry;
#pragma unroll
    for (int g = 3; g >= 0; --g) {
        const float e3 = (h == 0) ? Rr * PG[g] : Rr, e2 = e3 * R[4 * g + 3], e1 = e2 * R[4 * g + 2], e0 = e1 * R[4 * g + 1];
        z[4 * g + 3] *= e3; z[4 * g + 2] *= e2; z[4 * g + 1] *= e1; z[4 * g + 0] *= e0;
        Rr *= G[g] * PG[g];
    }
    carry = Rr;
}
DI bool sb_compute(LAS uchar* ldsK, LAS uchar* ldsV, int j, int jmax, int q0, int r, int h, const bf16x8 (&qf)[4], f32x16& o0, f32x16& o1, float& carry) {
    f32x16 s0, s1;
#pragma unroll
    for (int q = 0; q < 16; ++q) { s0[q] = 0.f; s1[q] = 0.f; }
    { bf16x8 a0[4], a1[4];
#pragma unroll
      for (int kb = 0; kb < 4; ++kb) { a0[kb] = *(const LAS bf16x8*)(ldsK + r * KP_SB + (16 * kb + 8 * h) * 2); a1[kb] = *(const LAS bf16x8*)(ldsK + (32 + r) * KP_SB + (16 * kb + 8 * h) * 2); }
#pragma unroll
      for (int kb = 0; kb < 4; ++kb) { s0 = MFMA32(a0[kb], qf[kb], s0); s1 = MFMA32(a1[kb], qf[kb], s1); }
      __builtin_amdgcn_sched_group_barrier(0x100, 8, 0);
      __builtin_amdgcn_sched_group_barrier(0x008, 8, 0); }
    const int tq = q0 + r - 64 * j; const bool diag = (j == jmax);
    sb_subtile(s1, diag, tq, 32, h, carry);
    sb_subtile(s0, diag, tq, 0, h, carry);
#pragma unroll
    for (int sub = 0; sub < 2; ++sub)
#pragma unroll
        for (int s = 0; s < 2; ++s) {
            u32x4 pw;
            if (sub == 0) { pw.x = pk2(s0[8 * s], s0[8 * s + 1]); pw.y = pk2(s0[8 * s + 2], s0[8 * s + 3]); pw.z = pk2(s0[8 * s + 4], s0[8 * s + 5]); pw.w = pk2(s0[8 * s + 6], s0[8 * s + 7]); }
            else          { pw.x = pk2(s1[8 * s], s1[8 * s + 1]); pw.y = pk2(s1[8 * s + 2], s1[8 * s + 3]); pw.z = pk2(s1[8 * s + 4], s1[8 * s + 5]); pw.w = pk2(s1[8 * s + 6], s1[8 * s + 7]); }
            const bf16x8 pb = __builtin_bit_cast(bf16x8, pw);
            const int koff = (32 * sub + 16 * s + 4 * h) * 2;
            { const s16x4 lo = *(const LAS s16x4*)(ldsV + r * VP + koff), hi = *(const LAS s16x4*)(ldsV + r * VP + koff + 16);
              o0 = MFMA32(__builtin_shufflevector(lo, hi, 0, 1, 2, 3, 4, 5, 6, 7), pb, o0); }
            { const s16x4 lo = *(const LAS s16x4*)(ldsV + (32 + r) * VP + koff), hi = *(const LAS s16x4*)(ldsV + (32 + r) * VP + koff + 16);
              o1 = MFMA32(__builtin_shufflevector(lo, hi, 0, 1, 2, 3, 4, 5, 6, 7), pb, o1); }
        }
    return __builtin_amdgcn_ballot_w64(carry == 0.f) == ~0ull;
}
#ifndef SB_WIN_BACK
#define SB_WIN_BACK 3
#endif
constexpr int SBW = 18432, SB_FLAGS = 132096;
DI void sb_unit(LAS uchar* lds, const bf16* Qs, const bf16* Ks, const bf16* Vt, bf16* O, int bh, int qb, int tid, int wid, int lane) {
    asm volatile("" : "+v"(tid), "+v"(lane));
    const int b = bh >> 3, hd = bh & 7, r = lane & 31, h = lane >> 5;
    const size_t tbase = (size_t)b * SEQ;
    const int q0 = qb * 256 + wid * 32;
    const int jmax = 4 * qb + (wid >> 1), jlo = (4 * qb - SB_WIN_BACK > 0) ? 4 * qb - SB_WIN_BACK : 0, ntw = 4 * qb + 4 - jlo;
    { const char* kgb = (const char*)(Ks + tbase * 512 + hd * 64); const char* vgb = (const char*)(Vt + (size_t)bh * 64 * SEQ);
      for (int p = wid; p < 18 * ntw; p += 8) {
          const int tw = p / 18, q = p - 18 * tw, qi = q < 9 ? q : q - 9, s = 64 * qi + lane, row = s / 9, c0 = s - 9 * row, c = c0 < 8 ? c0 : 7, j = jlo + tw;
          const char* g = (q < 9) ? kgb + (size_t)(64 * j + row) * 1024 + c * 16 : vgb + ((size_t)row * SEQ + 64 * j) * 2 + c * 16;
          __builtin_amdgcn_global_load_lds((const unsigned*)g, (LAS unsigned*)(lds + tw * SBW + (q < 9 ? 0 : 9216) + 1024 * qi), 16, 0, 0);
      } }
    bf16x8 qf[4];
    { const bf16* qp = Qs + (tbase + q0 + r) * 512 + hd * 64 + 8 * h;
#pragma unroll
      for (int kb = 0; kb < 4; ++kb) qf[kb] = *(const bf16x8*)(qp + 16 * kb); }
    f32x16 o0, o1;
#pragma unroll
    for (int q = 0; q < 16; ++q) { o0[q] = 0.f; o1[q] = 0.f; }
    float carry = 1.0f;
    volatile LAS unsigned* flags = (volatile LAS unsigned*)(lds + SB_FLAGS);
    asm volatile("s_waitcnt vmcnt(0)" ::: "memory");
    LBAR();
    bool done = false;
    if (wid >= 4) __builtin_amdgcn_s_setprio(1);
    for (int j = jmax; j >= jlo && !done; --j) { LAS uchar* sl = lds + (j - jlo) * SBW; done = sb_compute(sl, sl + 9216, j, jmax, q0, r, h, qf, o0, o1, carry); }
    __builtin_amdgcn_s_setprio(0);
    if (lane == 0) flags[16 + wid] = (!done && jlo > 0) ? 1u : 0u;
    LBAR();
    unsigned more = 0u;
#pragma unroll
    for (int w = 0; w < 8; ++w) more |= flags[16 + w];
    if (more) {
        const int ntg = jlo;
        const bf16* kg = Ks + (tbase + (tid >> 3)) * 512 + hd * 64 + (tid & 7) * 8;
        const bf16* vg = Vt + ((size_t)bh * 64 + (tid >> 3)) * SEQ + (tid & 7) * 8;
        struct KV2 { u32x4 ka, va; };
        KV2 R0, R1, R2;
        bool stop = false;
#define SB_LOAD(R, ii) do { const int jt_ = ntg - 1 - (ii); R.ka = *(const u32x4*)(kg + (size_t)(64 * jt_) * 512); R.va = *(const u32x4*)(vg + 64 * jt_); } while (0)
#define SB_STORE(R, bb) do { LAS uchar* kb_ = lds + (bb) * MLA_BUF; *(LAS u32x4*)(kb_ + (tid >> 3) * KP_SB + (tid & 7) * 16) = R.ka; *(LAS u32x4*)(kb_ + MLA_VOFF + (tid >> 3) * VP + (tid & 7) * 16) = R.va; } while (0)
#define SB_STEP(ii, R) do { const int i_ = (ii), j_ = ntg - 1 - i_; if (i_ + 1 < ntg) SB_STORE(R, (i_ + 1) & 1); if (i_ + 4 < ntg) SB_LOAD(R, i_ + 4); \
        if (!done && j_ <= jmax) { LAS uchar* kb2_ = lds + (i_ & 1) * MLA_BUF; done = sb_compute(kb2_, kb2_ + MLA_VOFF, j_, jmax, q0, r, h, qf, o0, o1, carry); } \
        if (lane == 0) flags[(i_ & 1) * 8 + wid] = done ? 1u : 0u; \
        LBAR(); \
        { unsigned all_ = 1u; _Pragma("unroll") for (int w_ = 0; w_ < 8; ++w_) all_ &= flags[(i_ & 1) * 8 + w_]; stop = all_ != 0u; } } while (0)
        SB_LOAD(R0, 0); if (ntg > 1) SB_LOAD(R1, 1); if (ntg > 2) SB_LOAD(R2, 2);
        SB_STORE(R0, 0); if (ntg > 3) SB_LOAD(R0, 3);
        LBAR();
        for (int i3 = 0; i3 < ntg; i3 += 3) {
            SB_STEP(i3, R1); if (stop || i3 + 1 >= ntg) break;
            SB_STEP(i3 + 1, R2); if (stop || i3 + 2 >= ntg) break;
            SB_STEP(i3 + 2, R0); if (stop) break;
        }
#undef SB_LOAD
#undef SB_STORE
#undef SB_STEP
    }
    LBAR();
    bf16* op = O + (tbase + q0 + r) * 512 + hd * 64 + 4 * h;
#pragma unroll
    for (int g = 0; g < 4; ++g) {
        u32x2 w0, w1; w0.x = pk2(o0[4 * g], o0[4 * g + 1]); w0.y = pk2(o0[4 * g + 2], o0[4 * g + 3]);
        w1.x = pk2(o1[4 * g], o1[4 * g + 1]); w1.y = pk2(o1[4 * g + 2], o1[4 * g + 3]);
        *(u32x2*)(op + 8 * g) = w0; *(u32x2*)(op + 32 + 8 * g) = w1;
    }
}

#define XB_TMO      128
#define XB_XCNT(j)  (256  + 64 * (j))
#define XB_XSUB(j)  (1280 + 64 * (j))
#define XB_XGEN(j)  (2304 + 64 * (j))
#define XB_TOP      3328
#define XB_TOPGEN   3392
#define XCD_BAR_WORDS 3456
#define XB_SPIN_CAP (1u << 18)

__device__ __forceinline__ unsigned xb_ld(unsigned* p)              { return __hip_atomic_load(p, __ATOMIC_RELAXED, __HIP_MEMORY_SCOPE_AGENT); }
__device__ __forceinline__ unsigned xb_add(unsigned* p, unsigned v) { return __hip_atomic_fetch_add(p, v, __ATOMIC_RELAXED, __HIP_MEMORY_SCOPE_AGENT); }
__device__ __forceinline__ unsigned xb_xcc_id() { return (unsigned)__builtin_amdgcn_s_getreg((3 << 11) | 20) & 0xFu; }
#define XB_SPIN(cond, bar) do { unsigned _sp = 0; while (cond) { __builtin_amdgcn_s_sleep(1); \
    if ((++_sp & 255u) == 0u) { if (xb_ld(&(bar)[XB_TMO])) break; if (_sp > XB_SPIN_CAP) { atomicAdd(&(bar)[XB_TMO], 1u); break; } } } } while (0)

struct XcdBarrier {
    unsigned* bar; unsigned x;
    volatile LAS unsigned* st;
};

__device__ __forceinline__ XcdBarrier xcd_barrier_post(unsigned* bar, volatile LAS unsigned* st, const bool is_t0) {
    XcdBarrier b; b.bar = bar; b.x = xb_xcc_id(); b.st = st;
    if (is_t0) (void)xb_add(&bar[XB_XCNT(b.x)], 1u);
    return b;
}
__device__ __forceinline__ void xcd_barrier_complete(unsigned* bar, unsigned x, unsigned& nloc, unsigned& nx) {
    const unsigned G = gridDim.x * gridDim.y * gridDim.z;
    unsigned sum, cnt, mine, sp = 0u;
    for (;;) {
        sum = 0u; cnt = 0u; mine = 0u;
#pragma unroll
        for (unsigned j = 0; j < 16; ++j) { const unsigned c = xb_ld(&bar[XB_XCNT(j)]); sum += c; cnt += (c > 0u) ? 1u : 0u; mine = (j == x) ? c : mine; }
        if (sum == G) break;
        __builtin_amdgcn_s_sleep(1);
        if ((++sp & 255u) == 0u) { if (xb_ld(&bar[XB_TMO])) break; if (sp > XB_SPIN_CAP) { atomicAdd(&bar[XB_TMO], 1u); break; } }
    }
    nloc = mine > 0u ? mine : 1u; nx = cnt > 0u ? cnt : 1u;
}

__device__ __forceinline__ void xcd_barrier(const XcdBarrier& b, const int wave_s) {
    unsigned z_ = 0u; asm volatile("" : "+v"(z_));
    const bool is_t0 = (wave_s == 0) && (__builtin_amdgcn_mbcnt_hi(~0u, __builtin_amdgcn_mbcnt_lo(~0u, z_)) == 0u);
    asm volatile("s_waitcnt vmcnt(0)" ::: "memory");
    __syncthreads();
    if (is_t0) {
        unsigned* bar = b.bar;
        __builtin_amdgcn_s_waitcnt(0);
        unsigned nloc = b.st[0], nx = b.st[1];
        if (nloc == 0u) { xcd_barrier_complete(bar, b.x, nloc, nx); b.st[0] = nloc; b.st[1] = nx; }
        const unsigned old = xb_add(&bar[XB_XSUB(b.x)], 1u);
        const unsigned gen = old / nloc;
        if (old + 1u == (gen + 1u) * nloc) {
            __builtin_amdgcn_fence(__ATOMIC_RELEASE, "agent");
            asm volatile("s_waitcnt vmcnt(0)" ::: "memory");
            const unsigned og = xb_add(&bar[XB_TOP], 1u);
            const unsigned tg = og / nx;
            if (og + 1u == (tg + 1u) * nx) xb_add(&bar[XB_TOPGEN], 1u);
            else XB_SPIN(xb_ld(&bar[XB_TOPGEN]) == tg, bar);
            __builtin_amdgcn_fence(__ATOMIC_ACQUIRE, "agent");
            xb_add(&bar[XB_XGEN(b.x)], 1u);
            asm volatile("s_waitcnt vmcnt(0)" ::: "memory");
        } else {
            XB_SPIN(xb_ld(&bar[XB_XGEN(b.x)]) == gen, bar);
            __builtin_amdgcn_fence(__ATOMIC_ACQUIRE, "agent");
            asm volatile("s_waitcnt vmcnt(0)" ::: "memory");
        }
    }
    __syncthreads();
}

__global__ void __launch_bounds__(512, 2) mega_fwd(Params P) {
    extern __shared__ __attribute__((aligned(16))) unsigned char lds_raw[];
    LAS uchar* lds = (LAS uchar*)lds_raw;
    cg::grid_group grid = cg::this_grid();
    const int wave_s = __builtin_amdgcn_readfirstlane(threadIdx.x >> 6);
    const int G = gridDim.x, NGW = G * 8, NT = G * 512;
#define FRESH() unsigned z_ = 0u; asm volatile("" : "+v"(z_)); const int tid = wave_s * 64 + (int)__builtin_amdgcn_mbcnt_hi(~0u, __builtin_amdgcn_mbcnt_lo(~0u, z_)); const int lane = tid & 63, wave = wave_s, gw = blockIdx.x * 8 + wave, gtid = blockIdx.x * 512 + tid; (void)lane; (void)gw; (void)gtid;
    unsigned char* ws = P.ws;
    const float* x = P.in[0];
    bf16* XN = (bf16*)(ws + WS_XN); float* H = (float*)(ws + WS_H); bf16* ACT = (bf16*)(ws + WS_ACT);
    bf16* CQ = (bf16*)(ws + WS_CQ); bf16* CKV = (bf16*)(ws + WS_CKV); float* KR = (float*)(ws + WS_KR);
    bf16* SBQ = (bf16*)(ws + WS_SBQ); bf16* SBK = (bf16*)(ws + WS_SBK); bf16* VTS = (bf16*)(ws + WS_VTS);
    bf16* QM = (bf16*)(ws + WS_QM); bf16* KM = (bf16*)(ws + WS_KM); bf16* VTM = (bf16*)(ws + WS_VTM);
    bf16* OM = (bf16*)(ws + WS_OM); bf16* OS = SBQ; bf16* MERGED = (bf16*)(ws + WS_MERGED); float* TMP = (float*)(ws + WS_TMP); bf16* PB = (bf16*)(ws + WS_PB);
    bf16* GATES = (bf16*)P.out;

#ifdef PROBE_A
    unsigned long long* tsbuf = (unsigned long long*)(ws + 900 * 1024); int n_stamp = 0;
#define STAMP() do { if (blockIdx.x == 0 && wave_s == 0 && __builtin_amdgcn_mbcnt_hi(~0u, __builtin_amdgcn_mbcnt_lo(~0u, 0u)) == 0u) tsbuf[n_stamp] = __builtin_amdgcn_s_memrealtime(); ++n_stamp; } while (0)
#else
#define STAMP() do {} while (0)
#endif
    STAMP();
    float* RS0 = (float*)(ws + WS_RS); float* RS1 = RS0 + T; float* RS2 = RS0 + 2 * T; float* RS3 = RS0 + 3 * T; float* RSQ = RS0 + 4 * T; float* RSKV = RS0 + 5 * T;
    bf16* HB2 = (bf16*)(ws + WS_HB2); bf16* HHI = (bf16*)(ws + WS_H); bf16* HLO = (bf16*)(ws + WS_H + 64 * MiB);
    unsigned* barw = (unsigned*)(ws + 904 * 1024);
    volatile LAS unsigned* bst = (volatile LAS unsigned*)(lds + 135168);
    if (threadIdx.x < 2) bst[threadIdx.x] = 0u;
    __syncthreads();
    if (P.ws == nullptr) grid.sync();
    const XcdBarrier xbar = xcd_barrier_post(barw, bst, wave_s == 0 && __builtin_amdgcn_mbcnt_hi(~0u, __builtin_amdgcn_mbcnt_lo(~0u, 0u)) == 0u);
    { FRESH(); for (int i = gtid; i < 5 * T / 4; i += NT) ((f32x4*)RS1)[i] = (f32x4){0.f, 0.f, 0.f, 0.f}; }
    { FRESH(); prep_weights(P, lds, gw, NGW, wave, lane); }
    { FRESH(); x_phase(x, XN, RS0, gw, NGW, lane); }
    { FRESH(); cvt_phase(P.in[1], PB, (size_t)T * 256 / 8, (size_t)gtid, (size_t)NT); }
    xcd_barrier(xbar, wave_s); STAMP();
    { Epi<M_SWIGLU> E{}; E.o0 = ACT; E.rs = RS0; E.rsn = 1.f / 1024.f; run_gemm<M_SWIGLU>(lds, XN, (const bf16*)(ws + WS_FF1IN), T, 2 * FF, DM, E, wave_s); }
    xcd_barrier(xbar, wave_s); STAMP();
    { Epi<M_RESID_FP> E{}; E.o0 = HHI; E.o1 = HLO; E.i0 = x; E.alpha = 0.5f; E.rso = RS1; run_gemm<M_RESID_FP>(lds, ACT, (const bf16*)(ws + WS_FF1OUT), T, DM, FF, E, wave_s); }
    xcd_barrier(xbar, wave_s); STAMP();
    { Epi<M_INPROJ> E{}; E.o0 = CQ; E.o1 = CKV; E.o2 = KR; E.o3 = SBQ; E.o4 = SBK; E.o5 = GATES; E.rs = RS1; E.rsn = 1.f / 1024.f; E.rso = RSQ; E.pos = (const int*)P.in[2]; E.g2 = P.in[13];
      run_gemm<M_INPROJ>(lds, HHI, (const bf16*)(ws + WS_WIN), T, 3840, DM, E, wave_s); }
    { Epi<M_VT> E{}; E.o0 = VTS; E.rs = RS1; E.rsn = 1.f / 1024.f; run_gemm<M_VT>(lds, (const bf16*)(ws + WS_WSBV), HHI, 512, T, DM, E, wave_s); }
    xcd_barrier(xbar, wave_s); STAMP();
    { Epi<M_QUP> E{}; E.o0 = QM; E.rs = RSQ; E.rsn = 1.f / 384.f; run_gemm<M_QUP>(lds, CQ, (const bf16*)(ws + WS_WQ), T, 768, 384, E, wave_s); }
    { Epi<M_KNOPE> E{}; E.o0 = KM; E.rs = RSKV; E.rsn = 1.f / 256.f; E.rs2 = RSKV + T; E.i0 = KR; E.g2 = P.in[13]; run_gemm<M_KNOPE>(lds, CKV, (const bf16*)(ws + WS_WKN), T, 512, 256, E, wave_s); }
    { Epi<M_VT> E{}; E.o0 = VTM; E.rs = RSKV; E.rsn = 1.f / 256.f; run_gemm<M_VT>(lds, (const bf16*)(ws + WS_WV), CKV, 512, T, 256, E, wave_s); }
    xcd_barrier(xbar, wave_s); STAMP();
    const int vcu = (G % 8 == 0) ? ((int)blockIdx.x % 8) * (G / 8) + (int)blockIdx.x / 8 : (int)blockIdx.x;
    { for (int pp = vcu; pp < 1024; pp += G) { FRESH(); const int c = pp & 255, k = pp >> 8, bh = c >> 2, s = c & 3;
        const int qb = k == 0 ? 15 - s : (k == 1 ? 8 + s : (k == 2 ? 7 - s : s));
        mla_unit(lds, QM, KM, VTM, OM, (const int*)P.in[2], P.in[12], P.in[13], bh, qb, tid, wave, lane); } }
    STAMP();
    { for (int uu = vcu; uu < 1024; uu += G) { FRESH(); sb_unit(lds, SBQ, SBK, VTS, OS, uu >> 4, uu & 15, tid, wave, lane); } }
    __syncthreads();
    xcd_barrier(xbar, wave_s); STAMP();
    { Epi<M_DUAL> E{}; E.o0 = MERGED; E.i0 = GATES; run_gemm_dual(lds, OM, (const bf16*)(ws + WS_WBM), OS, (const bf16*)(ws + WS_WBS), T, DM, 512, E, wave_s); }
    xcd_barrier(xbar, wave_s); STAMP();
    { Epi<M_RESID_PP> E{}; E.o0 = HB2; E.o1 = HLO; E.i0 = HHI; E.i1 = HLO; E.alpha = 1.0f; E.rso = RS2; run_gemm<M_RESID_PP>(lds, MERGED, (const bf16*)(ws + WS_WOUT), T, DM, DM, E, wave_s); }
    xcd_barrier(xbar, wave_s); STAMP();
    { Epi<M_SWIGLU> E{}; E.o0 = ACT; E.rs = RS2; E.rsn = 1.f / 1024.f; run_gemm<M_SWIGLU>(lds, HB2, (const bf16*)(ws + WS_FF2IN), T, 2 * FF, DM, E, wave_s); }
    xcd_barrier(xbar, wave_s); STAMP();
    { Epi<M_RESID_PP> E{}; E.o0 = XN; E.o1 = HLO; E.i0 = HB2; E.i1 = HLO; E.alpha = 0.5f; E.rso = RS3; run_gemm<M_RESID_PP>(lds, ACT, (const bf16*)(ws + WS_FF2OUT), T, DM, FF, E, wave_s); }
    xcd_barrier(xbar, wave_s); STAMP();
    { Epi<M_SIGM> E{}; E.o0 = TMP; E.rs = RS3; E.rsn = 1.f / 1024.f; run_gemm<M_SIGM>(lds, XN, (const bf16*)(ws + WS_WG), T, DM, DM, E, wave_s); }
    { Epi<M_FINAL> E{}; E.o0 = P.out; E.i0 = XN; E.o1 = HLO; E.i1 = TMP; run_gemm<M_FINAL>(lds, PB, (const bf16*)(ws + WS_WP), T, DM, 256, E, wave_s); }
#ifdef PROBE_A
    xcd_barrier(xbar, wave_s); STAMP();
    xcd_barrier(xbar, wave_s); STAMP();
    { const float pa = (float)(tsbuf[PROBE_B] - tsbuf[PROBE_A]) * 0.0001f, pb = (float)(tsbuf[PROBE_D] - tsbuf[PROBE_C]) * 0.000001f;
      FRESH();
      if (gtid == 0) P.out[0] += pa;
      for (int i = gtid; i < 4 * 1024 * 1024; i += NT) P.out[(size_t)4096 * 1024 + i] += pb; }
#endif
}

extern "C" void kernel_launch(void* const* d_in, const int* in_sizes, int n_in, void* d_out, int out_size, void* d_ws, size_t ws_size, hipStream_t stream) {
    static int grid = 0;
    if (grid == 0) {
        if (n_in != 23 || ws_size < WS_END) { fprintf(stderr, "kernel_launch: unexpected n_in %d / ws_size %zu\n", n_in, ws_size); grid = -1; return; }
        int dev = 0, cus = 0, per_cu = 0;
        hipGetDevice(&dev); hipDeviceGetAttribute(&cus, hipDeviceAttributeMultiprocessorCount, dev);
        if (hipFuncSetAttribute((const void*)mega_fwd, hipFuncAttributeMaxDynamicSharedMemorySize, LDS_BYTES) != hipSuccess) { fprintf(stderr, "hipFuncSetAttribute failed\n"); grid = -1; return; }
        if (hipOccupancyMaxActiveBlocksPerMultiprocessor(&per_cu, (const void*)mega_fwd, 512, LDS_BYTES) != hipSuccess || per_cu < 1) { fprintf(stderr, "occupancy query: %d\n", per_cu); per_cu = 1; }
        (void)hipGetLastError();
        grid = cus * per_cu;
    }
    if (grid < 0) return;
    Params p{};
    for (int i = 0; i < 23; ++i) p.in[i] = (const float*)d_in[i];
    p.out = (float*)d_out; p.ws = (unsigned char*)d_ws;
    if (hipMemsetAsync((char*)d_ws + 904 * 1024, 0, XCD_BAR_WORDS * sizeof(unsigned), stream) != hipSuccess) { fprintf(stderr, "kernel_launch: hipMemsetAsync of the barrier words failed\n"); return; }
    void* args[] = {&p};
    hipError_t e = hipLaunchCooperativeKernel((const void*)mega_fwd, dim3(grid), dim3(512), args, LDS_BYTES, stream);
    if (e != hipSuccess) fprintf(stderr, "cooperative launch failed: %s (grid %d)\n", hipGetErrorString(e), grid);
}
```

```cpp
#include <hip/hip_runtime.h>
#include <hip/hip_cooperative_groups.h>
#include <cstdio>
#include <cstdint>
namespace cg = cooperative_groups;
namespace pg8 {
#define PG8_LAS __attribute__((address_space(3)))
typedef unsigned short bf16_t;
typedef short bf16x8 __attribute__((ext_vector_type(8)));
typedef float f32x4 __attribute__((ext_vector_type(4)));
typedef unsigned u32x4 __attribute__((ext_vector_type(4)));
constexpr int BM = 256, BK = 64, HALF = 128, HTB = HALF * BK * 2  , STAGE_BYTES = 8 * HTB, NXCD = 8, WGM = 8;

__host__ __device__ __forceinline__ int lds_byte(int r, int c) { const int st = (r >> 4) * 2 + (c >> 5), rr = r & 15, cc = c & 31, ob = rr * 64 + cc * 2; return st * 1024 + (ob ^ (((ob >> 9) & 1) << 5)); }
__host__ __device__ __forceinline__ void stage_rc(int b, int& R, int& C) { const int st = b / 1024, sb = b % 1024, swz = sb ^ (((sb >> 9) & 1) << 5); R = (st >> 1) * 16 + swz / 64; C = (st & 1) * 32 + (swz % 64) / 2; }
__host__ __device__ __forceinline__ int perm32(int rho) { const int n = rho >> 4, i = rho & 15; return 8 * (i >> 2) + 4 * n + (i & 3); }

struct Unit { int pm, pn, half; };
struct Gemm { const bf16_t* A; const bf16_t* Bt; int M, N, K; const bf16_t* A2; const bf16_t* Bt2; };

struct StaticOrder {
    int nM, nN, nwg, G, c;
    __host__ __device__ void init(int M, int N, int G_, int c_) { nM = M / BM; nN = N / BM; nwg = nM * nN; G = G_; c = c_; }
    __host__ __device__ bool next(int i, Unit& u) const {
        const long L = (long)i * G + c; if (L >= nwg) return false;
        int wgid = (int)L; { const int q = nwg / NXCD, r = nwg % NXCD, xcd = wgid % NXCD, off = wgid / NXCD; wgid = (xcd < r ? xcd * (q + 1) : r * (q + 1) + (xcd - r) * q) + off; }
        const int nig = WGM * nN, gid = wgid / nig, fm = gid * WGM, gsz = (nM - fm) < WGM ? (nM - fm) : WGM;
        u.pm = fm + ((wgid % nig) % gsz); u.pn = (wgid % nig) / gsz; u.half = 0; return true;
    }
    __device__ __forceinline__ void a_ready(const Unit&) const {}
    __device__ __forceinline__ void done(const Unit&) const {}
};

__device__ __forceinline__ unsigned cvt_pk_bf16(float lo, float hi) { unsigned r; asm volatile("v_cvt_pk_bf16_f32 %0, %1, %2" : "=v"(r) : "v"(lo), "v"(hi)); return r; }
typedef float f32x2 __attribute__((ext_vector_type(2)));
template <class Epi, class Sched, bool ALIGN_EPI = false, bool SP2 = false>
__device__ __forceinline__ void gemm_phase(PG8_LAS unsigned char* lds, const Gemm g, const Sched& S, const Epi& E, const int wave_s) {
    unsigned z_ = 0u; asm volatile("" : "+v"(z_)); int tid_ = wave_s * 64 + (int)__builtin_amdgcn_mbcnt_hi(~0u, __builtin_amdgcn_mbcnt_lo(~0u, z_)); const int tid = tid_, wid = __builtin_amdgcn_readfirstlane(tid >> 6), lane = tid & 63, wr = wid >> 2, wc = wid & 3, fr = lane & 15, fq = lane >> 4;
    const int K = g.K, nt = K / BK;
    unsigned voffA[2], voffB[2];
#pragma unroll
    for (int i = 0; i < 2; ++i) { int R, C; stage_rc(tid * 16 + i * 8192, R, C); const int Rb = Epi::PERM ? ((R & ~31) + perm32(R & 31)) : R;
        voffA[i] = (unsigned)(R * K + C) * 2u; voffB[i] = (unsigned)(Rb * K + C) * 2u; }
    const size_t kstep = (size_t)(BK * 2);
    const size_t hstep = (size_t)HALF * K * 2;
    const size_t tstep = 2 * hstep;
    const unsigned ldsw = (unsigned)wid * 1024u;
    const int aoff = lds_byte(wr * 64 + fr, fq * 8), boff = lds_byte(wc * 32 + fr, fq * 8);
#define PG8_SA(b, h) (((b) * 2 + (h)) * HTB)
#define PG8_SB(b, h) ((4 + (b) * 2 + (h)) * HTB)
#define PG8_STAGE(bufoff, gbase, voff) do { _Pragma("unroll") for (int _i = 0; _i < 2; ++_i) \
        __builtin_amdgcn_global_load_lds((const unsigned*)((const char*)(gbase) + (voff)[_i]), (PG8_LAS unsigned*)(lds + (bufoff) + ldsw + _i * 8192), 16, 0, 0); } while (0)
#define PG8_LDA(dst, b, h) do { _Pragma("unroll") for (int m = 0; m < 4; ++m) _Pragma("unroll") for (int k = 0; k < 2; ++k) dst[m][k] = *(const PG8_LAS bf16x8*)(lds + PG8_SA(b, h) + aoff + m * 2048 + k * 1024); } while (0)
#define PG8_LDB(dst, b, h) do { _Pragma("unroll") for (int n = 0; n < 2; ++n) _Pragma("unroll") for (int k = 0; k < 2; ++k) dst[n][k] = *(const PG8_LAS bf16x8*)(lds + PG8_SB(b, h) + boff + n * 2048 + k * 1024); } while (0)
#define PG8_MMA(ai, bj, At, Bt) do { __builtin_amdgcn_s_setprio(1); _Pragma("unroll") for (int m = 0; m < 4; ++m) _Pragma("unroll") for (int n = 0; n < 2; ++n) _Pragma("unroll") for (int k = 0; k < 2; ++k) \
        acc[ai][bj][m][n] = __builtin_amdgcn_mfma_f32_16x16x32_bf16(Bt[n][k], At[m][k], acc[ai][bj][m][n], 0, 0, 0); __builtin_amdgcn_s_setprio(0); } while (0)
#define PG8_WAIT_V(n) asm volatile("s_waitcnt vmcnt(" #n ")" ::: "memory")
#define PG8_WAIT_L(n) asm volatile("s_waitcnt lgkmcnt(" #n ")" ::: "memory")
#define PG8_BAR __builtin_amdgcn_s_barrier()
#define PG8_SCHED __builtin_amdgcn_sched_barrier(0)
    Unit cur, nxt; int ui = 0;
    if (!S.next(0, cur)) return;
    f32x4 acc[2][2][4][2];
#pragma unroll
    for (int a = 0; a < 2; ++a)
#pragma unroll
        for (int b = 0; b < 2; ++b)
#pragma unroll
            for (int m = 0; m < 4; ++m)
#pragma unroll
                for (int n = 0; n < 2; ++n) acc[a][b][m][n] = (f32x4){0.f, 0.f, 0.f, 0.f};
    bf16x8 At[4][2], B0[2][2], B1[2][2];
    const char* cA = (const char*)(cur.half ? g.A2 : g.A) + (size_t)cur.pm * tstep; const char* cB = (const char*)(cur.half ? g.Bt2 : g.Bt) + (size_t)cur.pn * tstep;
    S.a_ready(cur);
    if constexpr (SP2) {
        PG8_STAGE(PG8_SB(0, 0), cB, voffB); PG8_STAGE(PG8_SB(0, 1), cB + hstep, voffB); PG8_STAGE(PG8_SA(0, 0), cA, voffA); PG8_STAGE(PG8_SA(0, 1), cA + hstep, voffA);
        if (wr == 1) PG8_BAR;
        PG8_WAIT_V(2); PG8_BAR;
        PG8_STAGE(PG8_SB(1, 0), cB + kstep, voffB); PG8_STAGE(PG8_SA(1, 0), cA + kstep, voffA); PG8_STAGE(PG8_SB(1, 1), cB + hstep + kstep, voffB);
        PG8_WAIT_V(6); PG8_BAR;
    } else {
        PG8_STAGE(PG8_SB(0, 0), cB, voffB); PG8_STAGE(PG8_SA(0, 0), cA, voffA); PG8_STAGE(PG8_SB(0, 1), cB + hstep, voffB); PG8_STAGE(PG8_SA(0, 1), cA + hstep, voffA);
        if (wr == 1) PG8_BAR;
        PG8_WAIT_V(4); PG8_BAR;
        PG8_STAGE(PG8_SB(1, 0), cB + kstep, voffB); PG8_STAGE(PG8_SA(1, 0), cA + kstep, voffA); PG8_STAGE(PG8_SB(1, 1), cB + hstep + kstep, voffB);
        PG8_WAIT_V(6); PG8_BAR;
    }
    for (;;) {
        const bool has_next = S.next(ui + 1, nxt);
        const char* nA = has_next ? (const char*)(nxt.half ? g.A2 : g.A) + (size_t)nxt.pm * tstep : cA; const char* nB = has_next ? (const char*)(nxt.half ? g.Bt2 : g.Bt) + (size_t)nxt.pn * tstep : cB;
        for (int t = 0; t < nt; t += 2) {
            const bool last = (t == nt - 2);
            const char* a1 = cA + (size_t)(t + 1) * kstep;
            const char* a2 = last ? nA : cA + (size_t)(t + 2) * kstep; const char* b2 = last ? nB : cB + (size_t)(t + 2) * kstep;
            const char* a3 = a2 + kstep; const char* b3 = b2 + kstep;
            if (last && has_next) S.a_ready(nxt);
            if constexpr (SP2) {
            PG8_LDB(B0, 0, 0); PG8_LDB(B1, 0, 1); PG8_SCHED; PG8_LDA(At, 0, 0); PG8_STAGE(PG8_SA(1, 1), a1 + hstep, voffA);
            PG8_WAIT_V(8); PG8_WAIT_L(0); PG8_BAR; PG8_MMA(0, 0, At, B0); PG8_MMA(0, 1, At, B1); PG8_BAR; PG8_SCHED;
            PG8_LDA(At, 0, 1); PG8_STAGE(PG8_SB(0, 0), b2, voffB); PG8_STAGE(PG8_SB(0, 1), b2 + hstep, voffB); PG8_STAGE(PG8_SA(0, 0), a2, voffA);
            PG8_WAIT_V(8); PG8_WAIT_L(0); PG8_BAR; PG8_MMA(1, 0, At, B0); PG8_MMA(1, 1, At, B1); PG8_BAR; PG8_SCHED;
            PG8_LDB(B0, 1, 0); PG8_LDB(B1, 1, 1); PG8_SCHED; PG8_LDA(At, 1, 0); PG8_STAGE(PG8_SA(0, 1), a2 + hstep, voffA);
            PG8_WAIT_V(8); PG8_WAIT_L(0); PG8_BAR; PG8_MMA(0, 0, At, B0); PG8_MMA(0, 1, At, B1); PG8_BAR; PG8_SCHED;
            PG8_LDA(At, 1, 1); PG8_STAGE(PG8_SB(1, 0), b3, voffB); PG8_STAGE(PG8_SB(1, 1), b3 + hstep, voffB); PG8_STAGE(PG8_SA(1, 0), a3, voffA);
            PG8_WAIT_V(8); PG8_WAIT_L(0); PG8_BAR; PG8_MMA(1, 0, At, B0); PG8_MMA(1, 1, At, B1); PG8_BAR; PG8_SCHED;
            } else {
            PG8_LDB(B0, 0, 0); PG8_SCHED; PG8_LDA(At, 0, 0); PG8_STAGE(PG8_SA(1, 1), a1 + hstep, voffA);
            PG8_WAIT_L(8); PG8_BAR; PG8_WAIT_L(0); PG8_MMA(0, 0, At, B0); PG8_BAR; PG8_SCHED;
            PG8_LDB(B1, 0, 1); PG8_STAGE(PG8_SB(0, 0), b2, voffB);
            PG8_BAR; PG8_WAIT_L(0); PG8_MMA(0, 1, At, B1); PG8_BAR;
            PG8_LDA(At, 0, 1); PG8_STAGE(PG8_SA(0, 0), a2, voffA);
            PG8_BAR; PG8_WAIT_L(0); PG8_MMA(1, 0, At, B0); PG8_BAR; PG8_SCHED;
            PG8_STAGE(PG8_SB(0, 1), b2 + hstep, voffB);
            PG8_WAIT_V(6); PG8_BAR; PG8_MMA(1, 1, At, B1); PG8_BAR;
            PG8_LDB(B0, 1, 0); PG8_SCHED; PG8_LDA(At, 1, 0); PG8_STAGE(PG8_SA(0, 1), a2 + hstep, voffA);
            PG8_WAIT_L(8); PG8_BAR; PG8_WAIT_L(0); PG8_MMA(0, 0, At, B0); PG8_BAR; PG8_SCHED;
            PG8_LDB(B1, 1, 1); PG8_STAGE(PG8_SB(1, 0), b3, voffB);
            PG8_BAR; PG8_WAIT_L(0); PG8_MMA(0, 1, At, B1); PG8_BAR;
            PG8_LDA(At, 1, 1); PG8_STAGE(PG8_SA(1, 0), a3, voffA);
            PG8_BAR; PG8_WAIT_L(0); PG8_MMA(1, 0, At, B0); PG8_BAR; PG8_SCHED;
            PG8_STAGE(PG8_SB(1, 1), b3 + hstep, voffB);
            PG8_WAIT_V(6); PG8_BAR; PG8_MMA(1, 1, At, B1); PG8_BAR;
            }
        }
        if constexpr (ALIGN_EPI) { if (wr == 0) PG8_BAR; }
        if constexpr (!Epi::AFTER_DRAIN) { E(acc, cur, wr, wc, fr, fq); S.done(cur); }
        if (!has_next) break;
        if (E.zero_after(cur))
#pragma unroll
        for (int a = 0; a < 2; ++a)
#pragma unroll
            for (int b = 0; b < 2; ++b)
#pragma unroll
                for (int m = 0; m < 4; ++m)
#pragma unroll
                    for (int n = 0; n < 2; ++n) acc[a][b][m][n] = (f32x4){0.f, 0.f, 0.f, 0.f};
        cur = nxt; cA = nA; cB = nB; ++ui;
        if constexpr (ALIGN_EPI) { if (wr == 1) PG8_BAR; }
    }
    PG8_WAIT_V(0);
    if constexpr (!ALIGN_EPI) { if (wr == 0) PG8_BAR; }
    PG8_BAR;
    if constexpr (Epi::AFTER_DRAIN) { E.fused(acc, cur, wr, wc, fr, fq, lds, wid, lane); S.done(cur); }
#undef PG8_SA
#undef PG8_SB
#undef PG8_STAGE
#undef PG8_LDA
#undef PG8_LDB
#undef PG8_MMA
#undef PG8_WAIT_V
#undef PG8_WAIT_L
#undef PG8_BAR
#undef PG8_SCHED
}
}
#ifndef PG8_SP2
#define PG8_SP2 true
#endif
#ifndef PG8_ALIGN
#define PG8_ALIGN true
#endif

#define LAS __attribute__((address_space(3)))
typedef unsigned char uchar;
typedef unsigned short bf16;
typedef unsigned u32x4 __attribute__((ext_vector_type(4)));
typedef unsigned u32x2 __attribute__((ext_vector_type(2)));
typedef float f32x4 __attribute__((ext_vector_type(4)));
typedef float f32x2 __attribute__((ext_vector_type(2)));
typedef float f32x16 __attribute__((ext_vector_type(16)));
typedef short bf16x8 __attribute__((ext_vector_type(8)));
typedef short s16x4 __attribute__((ext_vector_type(4)));
typedef __bf16 bf16x2_t __attribute__((ext_vector_type(2)));
#define DI __device__ __forceinline__
#define MFMA32(a, b, c) __builtin_amdgcn_mfma_f32_32x32x16_bf16((a), (b), (c), 0, 0, 0)

DI unsigned pk2(float a, float b) { f32x2 v = {a, b}; return __builtin_bit_cast(unsigned, __builtin_convertvector(v, bf16x2_t)); }
DI float bf_lo(unsigned u) { return __uint_as_float(u << 16); }
DI float bf_hi(unsigned u) { return __uint_as_float(u & 0xffff0000u); }
DI u32x4 pack8(f32x4 a, f32x4 b) { u32x4 w; w.x = pk2(a[0], a[1]); w.y = pk2(a[2], a[3]); w.z = pk2(b[0], b[1]); w.w = pk2(b[2], b[3]); return w; }
DI float sigmoidf_(float v) { return __builtin_amdgcn_rcpf(1.0f + __builtin_amdgcn_exp2f(-1.44269504089f * v)); }
DI float wave_sum(float v) {
#pragma unroll
    for (int o = 1; o < 64; o <<= 1) v += __shfl_xor(v, o);
    return v;
}

constexpr int T = 32768, DM = 1024, FF = 2816, SEQ = 4096;
constexpr float NORM_EPS = 1e-6f;
constexpr float LOG2E = 1.44269504089f;
constexpr float QSCALE_MLA = 0.10206207261596577f * 1.44269504089f;
constexpr float QSCALE_SB = 0.125f * 1.44269504089f;
constexpr size_t MiB = 1u << 20;
constexpr size_t WS_FF1IN = 1 * MiB, WS_FF1OUT = 12 * MiB, WS_FF2IN = 18 * MiB, WS_FF2OUT = 29 * MiB, WS_WIN = 35 * MiB, WS_WSBV = 43 * MiB,
                 WS_WQ = 44 * MiB, WS_WKN = 45 * MiB, WS_WV = 45 * MiB + 512 * 1024, WS_WBM = 46 * MiB, WS_WBS = 47 * MiB, WS_WOUT = 48 * MiB,
                 WS_WG = 50 * MiB, WS_WP = 52 * MiB;
constexpr size_t WS_XN = 54 * MiB, WS_H = 118 * MiB, WS_BIG = 246 * MiB;
constexpr size_t WS_KM = WS_XN, WS_MERGED = WS_XN;
constexpr size_t WS_ACT = WS_BIG, WS_CQ = WS_BIG, WS_CKV = WS_BIG + 24 * MiB, WS_OM = WS_BIG, WS_SBQ = WS_BIG + 40 * MiB, WS_SBK = WS_BIG + 72 * MiB,
                 WS_VTS = WS_BIG + 104 * MiB, WS_QM = WS_BIG + 136 * MiB, WS_VTM = WS_BIG + 184 * MiB, WS_KR = WS_BIG + 216 * MiB,
                 WS_TMP = WS_BIG + 72 * MiB, WS_HB2 = WS_BIG + 176 * MiB, WS_PB = WS_BIG + 240 * MiB, WS_END = WS_BIG + 256 * MiB;
constexpr size_t WS_RS = 0;
constexpr int LDS_BYTES = 147456;

struct Params { const float* in[23]; float* out; unsigned char* ws; };

struct Job { int src, K, Nsrc, Ndst, mode, off; unsigned long long dst; int gain, pad; };
constexpr int NJOBS = 15, NJOBS_EARLY = 7;
__constant__ Job c_jobs[NJOBS] = {
    {4, 1024, 5632, 5632, 1, 0, WS_FF1IN, 3, 0},   {5, 2816, 1024, 1024, 0, 0, WS_FF1OUT, -1, 0}, {7, 1024, 4256, 3840, 5, 0, WS_WIN, 6, 0},     {7, 1024, 4256, 512, 0, 1696, WS_WSBV, 6, 0},
    {9, 384, 768, 768, 0, 0, WS_WQ, 8, 0},         {11, 256, 1024, 512, 6, 0, WS_WKN, 10, 0},     {11, 256, 1024, 512, 3, 64, WS_WV, 10, 0},
    {18, 1024, 5632, 5632, 1, 0, WS_FF2IN, 17, 0}, {19, 2816, 1024, 1024, 0, 0, WS_FF2OUT, -1, 0}, {14, 512, 1024, 1024, 0, 0, WS_WBM, -1, 0},   {15, 512, 1024, 1024, 0, 0, WS_WBS, -1, 0},
    {16, 1024, 1024, 1024, 0, 0, WS_WOUT, -1, 0},  {21, 1024, 1024, 1024, 0, 0, WS_WG, 20, 0},    {22, 256, 1024, 1024, 0, 0, WS_WP, -1, 0},    {0, 0, 0, 0, 0, 0, 0, -1, 0}};
__constant__ float c_invf[16] = {1.0f, 0.5623413251903491f, 0.31622776601683794f, 0.1778279410038923f, 0.1f, 0.05623413251903491f, 0.03162277660168379f, 0.01778279410038923f,
                                 0.01f, 0.005623413251903491f, 0.0031622776601683794f, 0.001778279410038923f, 0.001f, 0.0005623413251903491f, 0.00031622776601683794f, 0.0001778279410038923f};

DI int map_col(int mode, int n0, int off) {
    if (mode == 0) return n0 + off;
    if (mode == 1) { const int pn = n0 >> 8, half = (n0 >> 7) & 1, j = n0 & 127; return half * FF + pn * 128 + j; }
    if (mode == 2) { const int h = n0 >> 7, j = n0 & 127; return j < 96 ? h * 96 + j : -1; }
    if (mode == 3) { const int h = n0 >> 6, j = n0 & 63; return h * 128 + j + off; }
    if (mode == 6) { const int pn = n0 >> 8, bj = (n0 >> 7) & 1, wc = (n0 >> 5) & 3; return 128 * (4 * pn + wc) + 32 * bj; }
    if (n0 < 672) return n0;
    if (n0 < 768) return -1;
    if (n0 < 1792) return n0 - 96;
    { const int g = n0 - 1792, gt = g >> 8, bj = (g >> 7) & 1; return 2208 + bj * 1024 + gt * 128 + (g & 127); }
}

struct TItem { const float* W; const float* gain; bf16* WT; int K, Nsrc, n0, sc, k0; };
DI void titem_decode(const Params& P, int it, TItem& t, int jlo, int jhi) {
    int r = it, j = jlo;
    for (; j < jhi; ++j) { const int n = (c_jobs[j].K >> 6) * (c_jobs[j].Ndst >> 5); if (r < n) break; r -= n; }
    const int nblk = c_jobs[j].Ndst >> 5, kb = r / nblk, nb = r % nblk;
    t.K = c_jobs[j].K; t.Nsrc = c_jobs[j].Nsrc; t.n0 = nb * 32; t.k0 = kb * 64; t.sc = map_col(c_jobs[j].mode, t.n0, c_jobs[j].off);
    t.W = P.in[c_jobs[j].src]; const int gi = c_jobs[j].gain; t.gain = gi >= 0 ? P.in[gi] : nullptr; t.WT = (bf16*)(P.ws + c_jobs[j].dst);
}
DI void titem_load(const TItem& t, f32x4 (&v)[8], float (&g)[8], int lane) {
#pragma unroll
    for (int i = 0; i < 8; ++i) { const int kk = (lane >> 3) + 8 * i;
        v[i] = (t.sc >= 0) ? *(const f32x4*)(t.W + (size_t)(t.k0 + kk) * t.Nsrc + t.sc + 4 * (lane & 7)) : (f32x4){0.f, 0.f, 0.f, 0.f};
        g[i] = t.gain ? t.gain[t.k0 + kk] : 1.0f; }
}
DI void titem_finish(const TItem& t, const f32x4 (&v)[8], const float (&g)[8], LAS float* scr, int lane) {
#pragma unroll
    for (int i = 0; i < 8; ++i) { const int kk = (lane >> 3) + 8 * i; LAS float* s = scr + kk * 33 + 4 * (lane & 7);
        s[0] = v[i][0] * g[i]; s[1] = v[i][1] * g[i]; s[2] = v[i][2] * g[i]; s[3] = v[i][3] * g[i]; }
    asm volatile("s_waitcnt lgkmcnt(0)" ::: "memory");
    const int c = lane & 7;
#pragma unroll
    for (int j = 0; j < 4; ++j) { const int n = (lane >> 3) + 8 * j; const LAS float* s = scr + (8 * c) * 33 + n;
        u32x4 o; o.x = pk2(s[0 * 33], s[1 * 33]); o.y = pk2(s[2 * 33], s[3 * 33]); o.z = pk2(s[4 * 33], s[5 * 33]); o.w = pk2(s[6 * 33], s[7 * 33]);
        *(u32x4*)(t.WT + (size_t)(t.n0 + n) * t.K + t.k0 + 8 * c) = o; }
    asm volatile("s_waitcnt lgkmcnt(0)" ::: "memory");
}
DI void prep_weights(const Params& P, LAS uchar* lds, int gw, int NGW, int wave, int lane, int jlo, int jhi) {
    LAS float* scr = (LAS float*)(lds + wave * 16384);
    int total = 0;
    for (int j = jlo; j < jhi; ++j) total += (c_jobs[j].K >> 6) * (c_jobs[j].Ndst >> 5);
    if (gw >= total) return;
    TItem cur, nxt; f32x4 va[8], vb[8]; float ga[8], gb[8];
    titem_decode(P, gw, cur, jlo, jhi); titem_load(cur, va, ga, lane);
    for (int it = gw; it < total; it += 2 * NGW) {
        const bool h1 = it + NGW < total, h2 = it + 2 * NGW < total;
        if (h1) { titem_decode(P, it + NGW, nxt, jlo, jhi); titem_load(nxt, vb, gb, lane); }
        titem_finish(cur, va, ga, scr, lane);
        if (h2) { titem_decode(P, it + 2 * NGW, cur, jlo, jhi); titem_load(cur, va, ga, lane); }
        if (h1) titem_finish(nxt, vb, gb, scr, lane);
    }
}

DI void rms_row_1024(const float* xrow, const float* gain, bf16* orow, int lane) {
    const f32x4* xr = (const f32x4*)xrow + lane;
    f32x4 v[4]; float s = 0.f;
#pragma unroll
    for (int j = 0; j < 4; ++j) { v[j] = xr[64 * j]; s += (v[j].x * v[j].x + v[j].y * v[j].y) + (v[j].z * v[j].z + v[j].w * v[j].w); }
    const float r = 1.0f / sqrtf(wave_sum(s) * (1.f / 1024.f) + NORM_EPS);
    u32x2* o8 = (u32x2*)orow + lane;
#pragma unroll
    for (int j = 0; j < 4; ++j) { const f32x4 g = ((const f32x4*)gain)[64 * j + lane]; u32x2 w; w.x = pk2((v[j].x * r) * g.x, (v[j].y * r) * g.y); w.y = pk2((v[j].z * r) * g.z, (v[j].w * r) * g.w); o8[64 * j] = w; }
}
DI void norm_phase(const float* X, const float* gain, bf16* O, int gw, int NGW, int lane) {
    for (int m = gw; m < T; m += NGW) rms_row_1024(X + (size_t)m * DM, gain, O + (size_t)m * DM, lane);
}
template <int NJ> DI void latent_norm_phase(bf16* X, const float* gain, int gw, int NGW, int lane) {
    for (int m = gw; m < T; m += NGW) {
        unsigned* row = (unsigned*)(X + (size_t)m * (128 * NJ)) + lane;
        unsigned u[NJ]; float s = 0.f;
#pragma unroll
        for (int j = 0; j < NJ; ++j) { u[j] = row[64 * j]; const float a = bf_lo(u[j]), b = bf_hi(u[j]); s += a * a + b * b; }
        const float r = 1.0f / sqrtf(wave_sum(s) * (1.f / (128.f * NJ)) + NORM_EPS);
#pragma unroll
        for (int j = 0; j < NJ; ++j) { const f32x2 g = ((const f32x2*)gain)[64 * j + lane]; row[64 * j] = pk2((bf_lo(u[j]) * r) * g.x, (bf_hi(u[j]) * r) * g.y); }
    }
}
DI void x_phase(const float* X, bf16* O, float* RS, int gw, int NGW, int lane) {
    for (int m = gw; m < T; m += 4 * NGW) {
        f32x4 v[4][4];
#pragma unroll
        for (int q = 0; q < 4; ++q) { const int mq = (m + q * NGW < T) ? m + q * NGW : m; const f32x4* xr = (const f32x4*)(X + (size_t)mq * DM) + lane;
#pragma unroll
            for (int j = 0; j < 4; ++j) v[q][j] = xr[64 * j]; }
#pragma unroll
        for (int q = 0; q < 4; ++q) { const int mq = m + q * NGW;
            if (mq < T) { float s = 0.f;
#pragma unroll
                for (int j = 0; j < 4; ++j) s += (v[q][j].x * v[q][j].x + v[q][j].y * v[q][j].y) + (v[q][j].z * v[q][j].z + v[q][j].w * v[q][j].w);
                s = wave_sum(s);
                u32x2* o = (u32x2*)(O + (size_t)mq * DM) + lane;
#pragma unroll
                for (int j = 0; j < 4; ++j) { u32x2 w; w.x = pk2(v[q][j].x, v[q][j].y); w.y = pk2(v[q][j].z, v[q][j].w); o[64 * j] = w; }
                if (lane == 0) RS[mq] = s; } }
    }
}
DI void cvt_phase(const float* X, bf16* O, size_t n8, size_t gtid, size_t NT) {
    for (size_t i = gtid; i < n8; i += 4 * NT) {
        f32x4 a[4], b[4];
#pragma unroll
        for (int q = 0; q < 4; ++q) { const size_t iq = (i + q * NT < n8) ? i + q * NT : i; a[q] = ((const f32x4*)X)[2 * iq]; b[q] = ((const f32x4*)X)[2 * iq + 1]; }
#pragma unroll
        for (int q = 0; q < 4; ++q) if (i + q * NT < n8) ((u32x4*)O)[i + q * NT] = pack8(a[q], b[q]);
    }
}

DI void qk_phase(bf16* Qm, bf16* Km, const float* KR, const int* positions, const float* gq, const float* gk, int gtid, int NT) {
    for (int it = gtid; it < 2 * T * 8; it += NT) {
        const bool isk = it >= T * 8; const int e = isk ? it - T * 8 : it; const int t = e >> 3;
        bf16* base = (isk ? Km : Qm) + (size_t)e * 96;
        float v[96];
#pragma unroll
        for (int c = 0; c < 8; ++c) { const u32x4 w = ((const u32x4*)base)[c];
            v[8 * c + 0] = bf_lo(w.x); v[8 * c + 1] = bf_hi(w.x); v[8 * c + 2] = bf_lo(w.y); v[8 * c + 3] = bf_hi(w.y); v[8 * c + 4] = bf_lo(w.z); v[8 * c + 5] = bf_hi(w.z); v[8 * c + 6] = bf_lo(w.w); v[8 * c + 7] = bf_hi(w.w); }
        if (isk) {
#pragma unroll
            for (int c = 0; c < 8; ++c) { const f32x4 w = ((const f32x4*)(KR + (size_t)t * 32))[c]; v[64 + 4 * c] = w.x; v[65 + 4 * c] = w.y; v[66 + 4 * c] = w.z; v[67 + 4 * c] = w.w; }
        } else {
#pragma unroll
            for (int c = 8; c < 12; ++c) { const u32x4 w = ((const u32x4*)base)[c];
                v[8 * c + 0] = bf_lo(w.x); v[8 * c + 1] = bf_hi(w.x); v[8 * c + 2] = bf_lo(w.y); v[8 * c + 3] = bf_hi(w.y); v[8 * c + 4] = bf_lo(w.z); v[8 * c + 5] = bf_hi(w.z); v[8 * c + 6] = bf_lo(w.w); v[8 * c + 7] = bf_hi(w.w); }
        }
        float ss = 0.f;
#pragma unroll
        for (int d = 0; d < 96; ++d) ss += v[d] * v[d];
        const float r = 1.0f / sqrtf(ss * (1.f / 96.f) + NORM_EPS);
        const float* g = isk ? gk : gq;
#pragma unroll
        for (int d = 0; d < 96; ++d) v[d] = (v[d] * r) * g[d];
        const float posf = (float)positions[t];
#pragma unroll
        for (int i = 0; i < 16; ++i) {
            const float ang = posf * c_invf[i];
            const double rev = (double)ang * 0.15915494309189535;
            const float fr = (float)(rev - rint(rev));
            const float cs = __builtin_amdgcn_cosf(fr), sn = __builtin_amdgcn_sinf(fr);
            const float x1 = v[64 + i], x2 = v[80 + i];
            v[64 + i] = x1 * cs - x2 * sn; v[80 + i] = x2 * cs + x1 * sn;
        }
        const float sc = isk ? 1.0f : QSCALE_MLA;
#pragma unroll
        for (int c = 0; c < 12; ++c) { u32x4 w; w.x = pk2(v[8 * c] * sc, v[8 * c + 1] * sc); w.y = pk2(v[8 * c + 2] * sc, v[8 * c + 3] * sc); w.z = pk2(v[8 * c + 4] * sc, v[8 * c + 5] * sc); w.w = pk2(v[8 * c + 6] * sc, v[8 * c + 7] * sc);
            ((u32x4*)base)[c] = w; }
    }
}

enum { M_SWIGLU = 0, M_RESID, M_INPROJ, M_QUP, M_KNOPE, M_VT, M_DUAL, M_SIGM, M_FINAL, M_RESID_FP, M_RESID_PP };
DI float sq8(const f32x4& a, const f32x4& b) { return (a[0] * a[0] + a[1] * a[1]) + (a[2] * a[2] + a[3] * a[3]) + (b[0] * b[0] + b[1] * b[1]) + (b[2] * b[2] + b[3] * b[3]); }
DI float quad_sum(float v) { v += __shfl_xor(v, 16); v += __shfl_xor(v, 32); return v; }
template <int MODE> struct Epi {
    static constexpr bool PERM = true, AFTER_DRAIN = false;
    void* o0; void* o1; void* o2; void* o3; void* o4; void* o5; const void* i0; const void* i1; float alpha;
    const float* rs; float rsn; float* rso; float* rso2; bf16* hb;
    const int* pos; const float* g2; const float* rs2;
    __device__ __forceinline__ bool zero_after(const pg8::Unit& u) const { if constexpr (MODE == M_DUAL) return u.half != 0; else return true; }
    __device__ __forceinline__ void operator()(pg8::f32x4 (&acc)[2][2][4][2], const pg8::Unit& u, int wr, int wc, int fr, int fq) const {
        const int rowb = u.pm * 256 + wr * 64 + fr;
        const int colb = u.pn * 256 + wc * 32 + 8 * fq;
        if constexpr (MODE == M_SWIGLU || MODE == M_INPROJ || MODE == M_QUP || MODE == M_SIGM) {
            float rsc[2][4];
#pragma unroll
            for (int ai = 0; ai < 2; ++ai)
#pragma unroll
                for (int m = 0; m < 4; ++m) rsc[ai][m] = rs[rowb + ai * 128 + m * 16];
#pragma unroll
            for (int ai = 0; ai < 2; ++ai)
#pragma unroll
                for (int m = 0; m < 4; ++m) rsc[ai][m] = __builtin_amdgcn_rsqf(rsc[ai][m] * rsn + NORM_EPS);
            if constexpr (MODE == M_SWIGLU) {
                const int col = u.pn * 128 + wc * 32 + 8 * fq;
#pragma unroll
                for (int ai = 0; ai < 2; ++ai)
#pragma unroll
                    for (int m = 0; m < 4; ++m) {
                        const float r = rsc[ai][m];
                        f32x4 a0 = acc[ai][0][m][0], a1 = acc[ai][0][m][1]; const f32x4 b0 = acc[ai][1][m][0], b1 = acc[ai][1][m][1];
#pragma unroll
                        for (int i = 0; i < 4; ++i) { const float x0 = a0[i] * r, x1 = a1[i] * r; a0[i] = x0 * sigmoidf_(x0) * (b0[i] * r); a1[i] = x1 * sigmoidf_(x1) * (b1[i] * r); }
                        *(u32x4*)((bf16*)o0 + (size_t)(rowb + ai * 128 + m * 16) * FF + col) = pack8(a0, a1);
                    }
            } else if constexpr (MODE == M_QUP) {
#pragma unroll
                for (int ai = 0; ai < 2; ++ai)
#pragma unroll
                    for (int m = 0; m < 4; ++m)
#pragma unroll
                        for (int bj = 0; bj < 2; ++bj)
                            *(u32x4*)((bf16*)o0 + (size_t)(rowb + ai * 128 + m * 16) * 768 + colb + bj * 128) = pack8(acc[ai][bj][m][0] * rsc[ai][m], acc[ai][bj][m][1] * rsc[ai][m]);
            } else if constexpr (MODE == M_SIGM) {
#pragma unroll
                for (int ai = 0; ai < 2; ++ai)
#pragma unroll
                    for (int m = 0; m < 4; ++m)
#pragma unroll
                        for (int bj = 0; bj < 2; ++bj) {
                            f32x4 v0 = acc[ai][bj][m][0] * rsc[ai][m], v1 = acc[ai][bj][m][1] * rsc[ai][m];
#pragma unroll
                            for (int i = 0; i < 4; ++i) { v0[i] = sigmoidf_(v0[i]); v1[i] = sigmoidf_(v1[i]); }
                            *(u32x4*)((bf16*)o0 + (size_t)(rowb + ai * 128 + m * 16) * DM + colb + bj * 128) = pack8(v0, v1);
                        }
            } else if (u.pn >= 7) {
                const int gcol = (u.pn - 7) * 128 + wc * 32 + 8 * fq;
#pragma unroll
                for (int ai = 0; ai < 2; ++ai)
#pragma unroll
                    for (int m = 0; m < 4; ++m) {
                        const int row = rowb + ai * 128 + m * 16; const float r = rsc[ai][m];
                        f32x4 a0 = acc[ai][0][m][0] * r, a1 = acc[ai][0][m][1] * r, b0 = acc[ai][1][m][0] * r, b1 = acc[ai][1][m][1] * r;
#pragma unroll
                        for (int i = 0; i < 4; ++i) { b0[i] = fmaxf(sigmoidf_(b0[i]), 1e-18f); b1[i] = fmaxf(sigmoidf_(b1[i]), 1e-18f);
                            a0[i] = sigmoidf_(a0[i]) * __builtin_amdgcn_rcpf(b0[i]); a1[i] = sigmoidf_(a1[i]) * __builtin_amdgcn_rcpf(b1[i]); }
                        bf16* gp = (bf16*)o5 + (size_t)row * 2048 + gcol;
                        *(u32x4*)gp = pack8(a0, a1); *(u32x4*)(gp + 1024) = pack8(b0, b1);
                    }
            } else {
#pragma unroll
                for (int ai = 0; ai < 2; ++ai)
#pragma unroll
                    for (int m = 0; m < 4; ++m) {
                        const int row = rowb + ai * 128 + m * 16; const float r = rsc[ai][m];
                        float ssq = 0.f, ssq2 = 0.f;
#pragma unroll
                        for (int bj = 0; bj < 2; ++bj) {
                            const int col0 = colb + bj * 128;
                            f32x4 v0 = acc[ai][bj][m][0] * r, v1 = acc[ai][bj][m][1] * r;
                            if (col0 < 384) { *(u32x4*)((bf16*)o0 + (size_t)row * 384 + col0) = pack8(v0, v1); ssq += sq8(v0, v1); }
                            else if (col0 < 640) { *(u32x4*)((bf16*)o1 + (size_t)row * 256 + (col0 - 384)) = pack8(v0, v1); ssq2 += sq8(v0, v1); }
                            else if (col0 < 672) {
                                const float sk = quad_sum(sq8(v0, v1));
                                if (fq == 0) rso[2 * T + row] = sk;
                                const int c0 = col0 - 640;
                                const f32x4 ga = *(const f32x4*)(g2 + 64 + c0), gb = *(const f32x4*)(g2 + 64 + c0 + 4);
                                v0 = v0 * ga; v1 = v1 * gb;
                                const float posf = (float)pos[row];
                                float xv[8] = {v0[0], v0[1], v0[2], v0[3], v1[0], v1[1], v1[2], v1[3]};
                                const int ib = (fq & 1) * 8; const bool second = fq >= 2;
#pragma unroll
                                for (int j = 0; j < 8; ++j) {
                                    const float other = __shfl_xor(xv[j], 32);
                                    const float ang = posf * c_invf[ib + j];
                                    const double rev = (double)ang * 0.15915494309189535;
                                    const float frc = (float)(rev - rint(rev));
                                    const float cs = __builtin_amdgcn_cosf(frc), sn = __builtin_amdgcn_sinf(frc);
                                    xv[j] = second ? (xv[j] * cs + other * sn) : (xv[j] * cs - other * sn);
                                }
                                float* kr = (float*)o2 + (size_t)row * 32 + c0;
                                *(f32x4*)kr = (f32x4){xv[0], xv[1], xv[2], xv[3]}; *(f32x4*)(kr + 4) = (f32x4){xv[4], xv[5], xv[6], xv[7]};
                            }
                            else if (col0 < 768) { }
                            else if (col0 < 1280) { *(u32x4*)((bf16*)o3 + (size_t)row * 512 + (col0 - 768)) = pack8(v0 * QSCALE_SB, v1 * QSCALE_SB); }
                            else if (col0 < 1792) { *(u32x4*)((bf16*)o4 + (size_t)row * 512 + (col0 - 1280)) = pack8(v0, v1); }
                            else { }
                        }
                        if (u.pn < 3) {
                            ssq = quad_sum(ssq); ssq2 = quad_sum(ssq2);
                            if (fq == 0) { if (u.pn < 2) unsafeAtomicAdd(rso + row, ssq); if (u.pn > 0) unsafeAtomicAdd(rso + T + row, ssq2); }
                        }
                    }
            }
        } else if constexpr (MODE == M_RESID || MODE == M_RESID_FP || MODE == M_RESID_PP) {
            constexpr int MB = (MODE == M_RESID_FP) ? 4 : 2;
#pragma unroll
            for (int ai = 0; ai < 2; ++ai)
#pragma unroll
            for (int mb = 0; mb < 4; mb += MB) {
                f32x4 pre[MB][2][2];
                if constexpr (MODE == M_RESID_FP) {
#pragma unroll
                    for (int m = 0; m < MB; ++m)
#pragma unroll
                        for (int bj = 0; bj < 2; ++bj) { const float* bp = (const float*)i0 + (size_t)(rowb + ai * 128 + (mb + m) * 16) * DM + colb + bj * 128; pre[m][bj][0] = *(const f32x4*)bp; pre[m][bj][1] = *(const f32x4*)(bp + 4); }
                } else {
                    u32x4 ph[MB][2], pl[MB][2];
#pragma unroll
                    for (int m = 0; m < MB; ++m)
#pragma unroll
                        for (int bj = 0; bj < 2; ++bj) { const size_t off = (size_t)(rowb + ai * 128 + (mb + m) * 16) * DM + colb + bj * 128; ph[m][bj] = *(const u32x4*)((const bf16*)i0 + off); pl[m][bj] = *(const u32x4*)((const bf16*)i1 + off); }
#pragma unroll
                    for (int m = 0; m < MB; ++m)
#pragma unroll
                        for (int bj = 0; bj < 2; ++bj) { const u32x4 a = ph[m][bj], b = pl[m][bj];
                            pre[m][bj][0] = (f32x4){bf_lo(a.x) + bf_lo(b.x), bf_hi(a.x) + bf_hi(b.x), bf_lo(a.y) + bf_lo(b.y), bf_hi(a.y) + bf_hi(b.y)};
                            pre[m][bj][1] = (f32x4){bf_lo(a.z) + bf_lo(b.z), bf_hi(a.z) + bf_hi(b.z), bf_lo(a.w) + bf_lo(b.w), bf_hi(a.w) + bf_hi(b.w)}; }
                }
#pragma unroll
                for (int m = 0; m < MB; ++m) {
                    const int row = rowb + ai * 128 + (mb + m) * 16; float ssq = 0.f;
#pragma unroll
                    for (int bj = 0; bj < 2; ++bj) {
                        const size_t off = (size_t)row * DM + colb + bj * 128;
                        const f32x4 r0 = pre[m][bj][0] + acc[ai][bj][mb + m][0] * alpha, r1 = pre[m][bj][1] + acc[ai][bj][mb + m][1] * alpha;
                        const u32x4 hi = pack8(r0, r1);
                        if constexpr (MODE == M_RESID) { *(f32x4*)((float*)o0 + off) = r0; *(f32x4*)((float*)o0 + off + 4) = r1; *(u32x4*)(hb + off) = hi; }
                        else {
                            const f32x4 d0 = {r0[0] - bf_lo(hi.x), r0[1] - bf_hi(hi.x), r0[2] - bf_lo(hi.y), r0[3] - bf_hi(hi.y)}, d1 = {r1[0] - bf_lo(hi.z), r1[1] - bf_hi(hi.z), r1[2] - bf_lo(hi.w), r1[3] - bf_hi(hi.w)};
                            *(u32x4*)((bf16*)o0 + off) = hi; *(u32x4*)((bf16*)o1 + off) = pack8(d0, d1);
                        }
                        ssq += sq8(r0, r1);
                    }
                    ssq = quad_sum(ssq);
                    if (fq == 0) unsafeAtomicAdd(rso + row, ssq);
                }
            }
        } else if constexpr (MODE == M_KNOPE) {
            const int hd = u.pn * 4 + wc;
#pragma unroll
            for (int ai = 0; ai < 2; ++ai) {
                float rkv[4], rkr[4]; f32x4 krr[4][2];
#pragma unroll
                for (int m = 0; m < 4; ++m) { const int row = rowb + ai * 128 + m * 16; rkv[m] = rs[row]; rkr[m] = rs2[row]; const float* kp = (const float*)i0 + (size_t)row * 32 + 8 * fq; krr[m][0] = *(const f32x4*)kp; krr[m][1] = *(const f32x4*)(kp + 4); }
                const f32x4 g00 = *(const f32x4*)(g2 + 8 * fq), g01 = *(const f32x4*)(g2 + 8 * fq + 4), g10 = *(const f32x4*)(g2 + 32 + 8 * fq), g11 = *(const f32x4*)(g2 + 32 + 8 * fq + 4);
#pragma unroll
                for (int m = 0; m < 4; ++m) {
                    const int row = rowb + ai * 128 + m * 16;
                    const float r = __builtin_amdgcn_rsqf(rkv[m] * rsn + NORM_EPS);
                    f32x4 a0 = acc[ai][0][m][0] * r, a1 = acc[ai][0][m][1] * r, b0 = acc[ai][1][m][0] * r, b1 = acc[ai][1][m][1] * r;
                    const float ss = quad_sum(sq8(a0, a1) + sq8(b0, b1)) + rkr[m];
                    const float rk = __builtin_amdgcn_rsqf(ss * (1.f / 96.f) + NORM_EPS);
                    bf16* kp = (bf16*)o0 + (size_t)row * 768 + hd * 96 + 8 * fq;
                    *(u32x4*)kp = pack8((a0 * rk) * g00, (a1 * rk) * g01);
                    *(u32x4*)(kp + 32) = pack8((b0 * rk) * g10, (b1 * rk) * g11);
                    *(u32x4*)(kp + 64) = pack8(krr[m][0] * rk, krr[m][1] * rk);
                }
            }
        } else if constexpr (MODE == M_VT) {
            f32x4 sc[2][2];
#pragma unroll
            for (int bj = 0; bj < 2; ++bj) { sc[bj][0] = *(const f32x4*)(rs + colb + bj * 128); sc[bj][1] = *(const f32x4*)(rs + colb + bj * 128 + 4); }
#pragma unroll
            for (int bj = 0; bj < 2; ++bj)
#pragma unroll
                for (int i = 0; i < 4; ++i) { sc[bj][0][i] = __builtin_amdgcn_rsqf(sc[bj][0][i] * rsn + NORM_EPS); sc[bj][1][i] = __builtin_amdgcn_rsqf(sc[bj][1][i] * rsn + NORM_EPS); }
#pragma unroll
            for (int ai = 0; ai < 2; ++ai)
#pragma unroll
                for (int m = 0; m < 4; ++m)
#pragma unroll
                    for (int bj = 0; bj < 2; ++bj) { const int col0 = colb + bj * 128;
                        *(u32x4*)((bf16*)o0 + (size_t)(col0 >> 12) * (512 * 4096) + (size_t)(rowb + ai * 128 + m * 16) * 4096 + (col0 & 4095)) = pack8(acc[ai][bj][m][0] * sc[bj][0], acc[ai][bj][m][1] * sc[bj][1]); }
        } else if constexpr (MODE == M_DUAL) {
            const bf16* G = (const bf16*)i0;
            if (u.half == 0) {
                u32x4 ga[2][4][2];
#pragma unroll
                for (int ai = 0; ai < 2; ++ai)
#pragma unroll
                    for (int m = 0; m < 4; ++m)
#pragma unroll
                        for (int bj = 0; bj < 2; ++bj) ga[ai][m][bj] = *(const u32x4*)(G + (size_t)(rowb + ai * 128 + m * 16) * 2048 + colb + bj * 128);
#pragma unroll
                for (int ai = 0; ai < 2; ++ai)
#pragma unroll
                    for (int m = 0; m < 4; ++m)
#pragma unroll
                        for (int bj = 0; bj < 2; ++bj) {
                            const u32x4 a = ga[ai][m][bj];
                            acc[ai][bj][m][0][0] *= bf_lo(a.x); acc[ai][bj][m][0][1] *= bf_hi(a.x); acc[ai][bj][m][0][2] *= bf_lo(a.y); acc[ai][bj][m][0][3] *= bf_hi(a.y);
                            acc[ai][bj][m][1][0] *= bf_lo(a.z); acc[ai][bj][m][1][1] *= bf_hi(a.z); acc[ai][bj][m][1][2] *= bf_lo(a.w); acc[ai][bj][m][1][3] *= bf_hi(a.w);
                        }
            } else {
                u32x4 gb[2][4][2];
#pragma unroll
                for (int ai = 0; ai < 2; ++ai)
#pragma unroll
                    for (int m = 0; m < 4; ++m)
#pragma unroll
                        for (int bj = 0; bj < 2; ++bj) gb[ai][m][bj] = *(const u32x4*)(G + (size_t)(rowb + ai * 128 + m * 16) * 2048 + 1024 + colb + bj * 128);
#pragma unroll
                for (int ai = 0; ai < 2; ++ai)
#pragma unroll
                    for (int m = 0; m < 4; ++m)
#pragma unroll
                        for (int bj = 0; bj < 2; ++bj) {
                            const u32x4 b = gb[ai][m][bj]; f32x4 v0 = acc[ai][bj][m][0], v1 = acc[ai][bj][m][1];
                            v0[0] *= bf_lo(b.x); v0[1] *= bf_hi(b.x); v0[2] *= bf_lo(b.y); v0[3] *= bf_hi(b.y); v1[0] *= bf_lo(b.z); v1[1] *= bf_hi(b.z); v1[2] *= bf_lo(b.w); v1[3] *= bf_hi(b.w);
                            *(u32x4*)((bf16*)o0 + (size_t)(rowb + ai * 128 + m * 16) * DM + colb + bj * 128) = pack8(v0, v1);
                        }
            }
        } else if constexpr (MODE == M_FINAL) {
#pragma unroll
            for (int ai = 0; ai < 2; ++ai)
#pragma unroll
            for (int mh = 0; mh < 2; ++mh) {
                u32x4 ph[2][2], pl[2][2], gt[2][2];
#pragma unroll
                for (int m = 0; m < 2; ++m)
#pragma unroll
                    for (int bj = 0; bj < 2; ++bj) { const size_t off = (size_t)(rowb + ai * 128 + (mh * 2 + m) * 16) * DM + colb + bj * 128;
                        ph[m][bj] = *(const u32x4*)((const bf16*)i0 + off); pl[m][bj] = *(const u32x4*)((const bf16*)o1 + off); gt[m][bj] = *(const u32x4*)((const bf16*)i1 + off); }
#pragma unroll
                for (int m = 0; m < 2; ++m)
#pragma unroll
                    for (int bj = 0; bj < 2; ++bj) { const size_t off = (size_t)(rowb + ai * 128 + (mh * 2 + m) * 16) * DM + colb + bj * 128;
                        const u32x4 g = gt[m][bj], a = ph[m][bj], b = pl[m][bj]; const f32x4 v0 = acc[ai][bj][mh * 2 + m][0], v1 = acc[ai][bj][mh * 2 + m][1]; f32x4 r0, r1;
                        r0[0] = (bf_lo(a.x) + bf_lo(b.x)) + bf_lo(g.x) * v0[0]; r0[1] = (bf_hi(a.x) + bf_hi(b.x)) + bf_hi(g.x) * v0[1]; r0[2] = (bf_lo(a.y) + bf_lo(b.y)) + bf_lo(g.y) * v0[2]; r0[3] = (bf_hi(a.y) + bf_hi(b.y)) + bf_hi(g.y) * v0[3];
                        r1[0] = (bf_lo(a.z) + bf_lo(b.z)) + bf_lo(g.z) * v1[0]; r1[1] = (bf_hi(a.z) + bf_hi(b.z)) + bf_hi(g.z) * v1[1]; r1[2] = (bf_lo(a.w) + bf_lo(b.w)) + bf_lo(g.w) * v1[2]; r1[3] = (bf_hi(a.w) + bf_hi(b.w)) + bf_hi(g.w) * v1[3];
                        *(f32x4*)((float*)o0 + off) = r0; *(f32x4*)((float*)o0 + off + 4) = r1; }
            }
        }
    }
};
struct DualOrder {
    pg8::StaticOrder S;
    __device__ bool next(int i, pg8::Unit& u) const { const bool ok = S.next(i >> 1, u); u.half = i & 1; return ok; }
    __device__ __forceinline__ void a_ready(const pg8::Unit&) const {}
    __device__ __forceinline__ void done(const pg8::Unit&) const {}
};
template <int MODE> DI void run_gemm(LAS uchar* lds, const bf16* A, const bf16* Bt, int M, int N, int K, const Epi<MODE>& E, int wave_s) {
    asm volatile("" : "+s"(M), "+s"(N), "+s"(K));
    pg8::Gemm g{A, Bt, M, N, K, nullptr, nullptr}; pg8::StaticOrder S; S.init(M, N, (int)gridDim.x, (int)blockIdx.x);
    pg8::gemm_phase<Epi<MODE>, pg8::StaticOrder, PG8_ALIGN, PG8_SP2>(lds, g, S, E, wave_s);
}
DI void run_gemm_dual(LAS uchar* lds, const bf16* A, const bf16* Bt, const bf16* A2, const bf16* Bt2, int M, int N, int K, const Epi<M_DUAL>& E, int wave_s) {
    asm volatile("" : "+s"(M), "+s"(N), "+s"(K));
    pg8::Gemm g{A, Bt, M, N, K, A2, Bt2}; DualOrder S; S.S.init(M, N, (int)gridDim.x, (int)blockIdx.x);
    pg8::gemm_phase<Epi<M_DUAL>, DualOrder, PG8_ALIGN, PG8_SP2>(lds, g, S, E, wave_s);
}

DI int crow(int reg, int h) { return (reg & 3) + 8 * (reg >> 2) + 4 * h; }
constexpr int KP_MLA = 208, KP_SB = 144, VP = 144;
constexpr int LDS_K = 0, LDS_V = 16384, LDS_FLAGS = 32768;

constexpr int MLA_BUF = 24576, MLA_VOFF = 13312;
#define LBAR() do { asm volatile("s_waitcnt lgkmcnt(0)" ::: "memory"); __builtin_amdgcn_s_barrier(); asm volatile("" ::: "memory"); } while (0)
constexpr int MLA_SUB = 22528, MLA_BIG = 2 * MLA_SUB;
DI void mla_qk_t(LAS uchar* ldsK, int r, int h, const f32x16& negv, const bf16x8 (&qf)[6], f32x16& s0, f32x16& s1) {
    bf16x8 a0[6], a1[6];
#pragma unroll
    for (int kb = 0; kb < 6; ++kb) { a0[kb] = *(const LAS bf16x8*)(ldsK + r * KP_MLA + (16 * kb + 8 * h) * 2); a1[kb] = *(const LAS bf16x8*)(ldsK + (32 + r) * KP_MLA + (16 * kb + 8 * h) * 2); }
    s0 = MFMA32(a0[0], qf[0], negv); s1 = MFMA32(a1[0], qf[0], negv);
#pragma unroll
    for (int kb = 1; kb < 6; ++kb) { s0 = MFMA32(a0[kb], qf[kb], s0); s1 = MFMA32(a1[kb], qf[kb], s1); }
}
DI void mla_sm_t(f32x16& s0, f32x16& s1, bf16x8 (&P)[4], float& lrun) {
#pragma unroll
    for (int i = 0; i < 16; ++i) { s0[i] = __builtin_amdgcn_exp2f(s0[i]); s1[i] = __builtin_amdgcn_exp2f(s1[i]); }
    float pa[8];
#pragma unroll
    for (int i = 0; i < 8; ++i) pa[i] = (s0[i] + s0[8 + i]) + (s1[i] + s1[8 + i]);
    lrun += ((pa[0] + pa[1]) + (pa[2] + pa[3])) + ((pa[4] + pa[5]) + (pa[6] + pa[7]));
#pragma unroll
    for (int t = 0; t < 2; ++t) {
        u32x4 pa, pb;
        pa.x = pk2(s0[8 * t], s0[8 * t + 1]); pa.y = pk2(s0[8 * t + 2], s0[8 * t + 3]); pa.z = pk2(s0[8 * t + 4], s0[8 * t + 5]); pa.w = pk2(s0[8 * t + 6], s0[8 * t + 7]);
        pb.x = pk2(s1[8 * t], s1[8 * t + 1]); pb.y = pk2(s1[8 * t + 2], s1[8 * t + 3]); pb.z = pk2(s1[8 * t + 4], s1[8 * t + 5]); pb.w = pk2(s1[8 * t + 6], s1[8 * t + 7]);
        P[t] = __builtin_bit_cast(bf16x8, pa); P[2 + t] = __builtin_bit_cast(bf16x8, pb);
    }
}
DI void mla_pv_t(LAS uchar* ldsV, int r, int h, const bf16x8 (&P)[4], f32x16& o0, f32x16& o1) {
#pragma unroll
    for (int q = 0; q < 4; ++q) {
        const int koff = (16 * q + 4 * h) * 2;
        { const s16x4 lo = *(const LAS s16x4*)(ldsV + r * VP + koff), hi = *(const LAS s16x4*)(ldsV + r * VP + koff + 16);
          o0 = MFMA32(__builtin_shufflevector(lo, hi, 0, 1, 2, 3, 4, 5, 6, 7), P[q], o0); }
        { const s16x4 lo = *(const LAS s16x4*)(ldsV + (32 + r) * VP + koff), hi = *(const LAS s16x4*)(ldsV + (32 + r) * VP + koff + 16);
          o1 = MFMA32(__builtin_shufflevector(lo, hi, 0, 1, 2, 3, 4, 5, 6, 7), P[q], o1); }
    }
}
DI void mla_step2(LAS uchar* buf, int J, int jmax, int q0, int r, int h, const f32x16& negv, const bf16x8 (&qf)[6], f32x16& o0, f32x16& o1, float& lrun) {
    const int j0 = 2 * J;
    if (j0 + 1 < jmax) {
        f32x16 sa0, sa1, sb0, sb1; bf16x8 Pa[4], Pb[4];
        mla_qk_t(buf, r, h, negv, qf, sa0, sa1);
        mla_qk_t(buf + MLA_SUB, r, h, negv, qf, sb0, sb1);
        mla_sm_t(sa0, sa1, Pa, lrun);
        mla_pv_t(buf + MLA_VOFF, r, h, Pa, o0, o1);
        mla_sm_t(sb0, sb1, Pb, lrun);
        mla_pv_t(buf + MLA_SUB + MLA_VOFF, r, h, Pb, o0, o1);
        __builtin_amdgcn_sched_group_barrier(0x100, 12, 0); __builtin_amdgcn_sched_group_barrier(0x008, 12, 0);
        __builtin_amdgcn_sched_group_barrier(0x100, 12, 0);
#pragma unroll
        for (int g_ = 0; g_ < 12; ++g_) { __builtin_amdgcn_sched_group_barrier(0x008, 1, 0); __builtin_amdgcn_sched_group_barrier(0x002, 8, 0); }
    } else {
#pragma unroll
        for (int sub = 0; sub < 2; ++sub) {
            const int j = j0 + sub;
            if (j <= jmax) {
                f32x16 s0, s1; bf16x8 P[4];
                mla_qk_t(buf + sub * MLA_SUB, r, h, negv, qf, s0, s1);
                __builtin_amdgcn_sched_group_barrier(0x100, 12, 0); __builtin_amdgcn_sched_group_barrier(0x008, 12, 0);
                if (j == jmax) { const int tq = q0 + r - 64 * j;
#pragma unroll
                    for (int i = 0; i < 16; ++i) { if (crow(i, h) > tq) s0[i] = -INFINITY; if (32 + crow(i, h) > tq) s1[i] = -INFINITY; } }
                mla_sm_t(s0, s1, P, lrun);
                mla_pv_t(buf + sub * MLA_SUB + MLA_VOFF, r, h, P, o0, o1);
            }
        }
    }
}
DI void mla_unit(LAS uchar* lds, const bf16* Qm, const bf16* Km, const bf16* Vt, bf16* O, const int* positions, const float* gq, const float* gk, int bh, int qb, int tid, int wid, int lane) {
    asm volatile("" : "+v"(tid), "+v"(lane));
    asm volatile("" : "+s"(gq), "+s"(gk));
    const int b = bh >> 3, hd = bh & 7, r = lane & 31, h = lane >> 5;
    const size_t tbase = (size_t)b * SEQ;
    const int q0 = qb * 256 + wid * 32;
    const int nt = 4 * (qb + 1), jmax = 4 * qb + (wid >> 1);
    const int NT2 = nt >> 1;
    const char* kg = (const char*)(Km + tbase * 768 + hd * 96);
    const char* vg = (const char*)(Vt + (size_t)bh * 64 * SEQ);
    unsigned dvo[3], dts[3], dlo[3]; const char* dgb[3];
#pragma unroll
    for (int k = 0; k < 3; ++k) { const int q = wid + 8 * k;
        if (q < 13) { const int s = 64 * q + lane, row = s / 13, c = s % 13; dgb[k] = kg; dts[k] = 64u * 1536u; dvo[k] = (unsigned)(row * 1536 + (c < 12 ? c : 11) * 16); dlo[k] = 1024u * q; }
        else { const int i = q - 13, s = 64 * i + lane, row = s / 9, c = s % 9; dgb[k] = vg; dts[k] = 128u; dvo[k] = (unsigned)(row * (SEQ * 2) + (c < 8 ? c : 7) * 16); dlo[k] = MLA_VOFF + 1024u * i; } }
    const bool three = wid < 6;
#define MLA_ISSUE1(jt, off) do { _Pragma("unroll") for (int k_ = 0; k_ < 3; ++k_) if (k_ < 2 || three) \
        __builtin_amdgcn_global_load_lds((const unsigned*)(dgb[k_] + (size_t)(jt) * dts[k_] + dvo[k_]), (LAS unsigned*)(lds + (off) + dlo[k_]), 16, 0, 0); } while (0)
#define MLA_ISSUE2(JJ) do { const int bo_ = ((JJ) % 3) * MLA_BIG; MLA_ISSUE1(2 * (JJ), bo_); MLA_ISSUE1(2 * (JJ) + 1, bo_ + MLA_SUB); } while (0)
    MLA_ISSUE2(0); if (NT2 > 1) MLA_ISSUE2(1);
    __builtin_amdgcn_sched_barrier(0);
    bf16x8 qf[6]; float negm;
    { const bf16* qp = Qm + (tbase + q0 + r) * 768 + hd * 96 + 8 * h;
      float gmax = 0.f;
#pragma unroll
      for (int kb = 0; kb < 6; ++kb) { const f32x4 ka = *(const f32x4*)(gk + 16 * kb + 8 * h), kb4 = *(const f32x4*)(gk + 16 * kb + 8 * h + 4);
#pragma unroll
          for (int j = 0; j < 4; ++j) gmax = fmaxf(gmax, fmaxf(fabsf(ka[j]), fabsf(kb4[j]))); }
      gmax = fmaxf(gmax, __shfl_xor(gmax, 32));
      asm volatile("" : "+v"(gmax));
      float qv[6][8]; float ss = 0.f;
#pragma unroll
      for (int kb = 0; kb < 6; ++kb) { const u32x4 w = *(const u32x4*)(qp + 16 * kb);
          qv[kb][0] = bf_lo(w.x); qv[kb][1] = bf_hi(w.x); qv[kb][2] = bf_lo(w.y); qv[kb][3] = bf_hi(w.y); qv[kb][4] = bf_lo(w.z); qv[kb][5] = bf_hi(w.z); qv[kb][6] = bf_lo(w.w); qv[kb][7] = bf_hi(w.w); }
#pragma unroll
      for (int kb = 0; kb < 6; ++kb)
#pragma unroll
          for (int j = 0; j < 8; ++j) ss += qv[kb][j] * qv[kb][j];
      ss += __shfl_xor(ss, 32);
      const float rq = __builtin_amdgcn_rsqf(ss * (1.f / 96.f) + NORM_EPS);
      float qn2 = 0.f;
#pragma unroll
      for (int kb = 0; kb < 6; ++kb) { const f32x4 ga = *(const f32x4*)(gq + 16 * kb + 8 * h), gb = *(const f32x4*)(gq + 16 * kb + 8 * h + 4);
#pragma unroll
          for (int j = 0; j < 4; ++j) { qv[kb][j] = (qv[kb][j] * rq) * ga[j]; qv[kb][4 + j] = (qv[kb][4 + j] * rq) * gb[j];
              qn2 += qv[kb][j] * qv[kb][j] + qv[kb][4 + j] * qv[kb][4 + j]; } }
      qn2 += __shfl_xor(qn2, 32);
      negm = -(1.02f * QSCALE_MLA * 9.79795897f) * sqrtf(qn2) * gmax;
      const float posf = (float)positions[tbase + q0 + r];
#pragma unroll
      for (int j = 0; j < 8; ++j) {
          const float ang = posf * c_invf[8 * h + j];
          const double rev = (double)ang * 0.15915494309189535;
          const float frc = (float)(rev - rint(rev));
          const float cs = __builtin_amdgcn_cosf(frc), sn = __builtin_amdgcn_sinf(frc);
          const float x1 = qv[4][j], x2 = qv[5][j];
          qv[4][j] = x1 * cs - x2 * sn; qv[5][j] = x2 * cs + x1 * sn;
      }
#pragma unroll
      for (int kb = 0; kb < 6; ++kb) { u32x4 w; w.x = pk2(qv[kb][0] * QSCALE_MLA, qv[kb][1] * QSCALE_MLA); w.y = pk2(qv[kb][2] * QSCALE_MLA, qv[kb][3] * QSCALE_MLA); w.z = pk2(qv[kb][4] * QSCALE_MLA, qv[kb][5] * QSCALE_MLA); w.w = pk2(qv[kb][6] * QSCALE_MLA, qv[kb][7] * QSCALE_MLA);
          qf[kb] = __builtin_bit_cast(bf16x8, w); } }
    f32x16 o0, o1;
#pragma unroll
    for (int i = 0; i < 16; ++i) { o0[i] = 0.f; o1[i] = 0.f; }
    float lrun = 0.f;
    f32x16 negv;
#pragma unroll
    for (int i = 0; i < 16; ++i) negv[i] = negm;
    asm volatile("" : "+v"(negv));
    if (NT2 > 1) { if (three) asm volatile("s_waitcnt vmcnt(6)" ::: "memory"); else asm volatile("s_waitcnt vmcnt(4)" ::: "memory"); } else asm volatile("s_waitcnt vmcnt(0)" ::: "memory");
    LBAR();
    for (int J = 0; J < NT2; ++J) {
        if (J + 2 < NT2) MLA_ISSUE2(J + 2);
        if (2 * J <= jmax) mla_step2(lds + (J % 3) * MLA_BIG, J, jmax, q0, r, h, negv, qf, o0, o1, lrun);
        if (J + 2 < NT2) { if (three) asm volatile("s_waitcnt vmcnt(6)" ::: "memory"); else asm volatile("s_waitcnt vmcnt(4)" ::: "memory"); }
        else asm volatile("s_waitcnt vmcnt(0)" ::: "memory");
        LBAR();
    }
#undef MLA_ISSUE1
#undef MLA_ISSUE2
#define MLA_STEP 0
#undef MLA_STEP
#undef MLA_LOAD
#undef MLA_STORE
    lrun += __shfl_xor(lrun, 32);
    const float inv = 1.0f / lrun;
    bf16* op = O + (tbase + q0 + r) * 512 + hd * 64 + 4 * h;
#pragma unroll
    for (int g = 0; g < 4; ++g) {
        u32x2 w0, w1; w0.x = pk2(o0[4 * g] * inv, o0[4 * g + 1] * inv); w0.y = pk2(o0[4 * g + 2] * inv, o0[4 * g + 3] * inv);
        w1.x = pk2(o1[4 * g] * inv, o1[4 * g + 1] * inv); w1.y = pk2(o1[4 * g + 2] * inv, o1[4 * g + 3] * inv);
        *(u32x2*)(op + 8 * g) = w0; *(u32x2*)(op + 32 + 8 * g) = w1;
    }
}

DI void sb_subtile(f32x16& z, bool diag, int tq, int koffs, int h, float& carry) {
    float R[16];
#pragma unroll
    for (int i = 0; i < 16; ++i) { const bool msk = diag && (koffs + crow(i, h) >= tq); const float E = __builtin_amdgcn_exp2f(fminf(z[i], 100.f)); const float rr = __builtin_amdgcn_rcpf(1.0f + E);
        R[i] = msk ? 1.0f : rr; z[i] = msk ? 0.f : E * rr; }
    float G[4], PG[4];
#pragma unroll
    for (int g = 0; g < 4; ++g) { G[g] = (R[4 * g] * R[4 * g + 1]) * (R[4 * g + 2] * R[4 * g + 3]); PG[g] = __shfl_xor(G[g], 32); }
    float Rr = carry;
#pragma unroll
    for (int g = 3; g >= 0; --g) {
        const float e3 = (h == 0) ? Rr * PG[g] : Rr, e2 = e3 * R[4 * g + 3], e1 = e2 * R[4 * g + 2], e0 = e1 * R[4 * g + 1];
        z[4 * g + 3] *= e3; z[4 * g + 2] *= e2; z[4 * g + 1] *= e1; z[4 * g + 0] *= e0;
        Rr *= G[g] * PG[g];
    }
    carry = Rr;
}
DI bool sb_compute(LAS uchar* ldsK, LAS uchar* ldsV, int j, int jmax, int q0, int r, int h, const bf16x8 (&qf)[4], f32x16& o0, f32x16& o1, float& carry) {
    f32x16 s0, s1;
#pragma unroll
    for (int q = 0; q < 16; ++q) { s0[q] = 0.f; s1[q] = 0.f; }
    { bf16x8 a0[4], a1[4];
#pragma unroll
      for (int kb = 0; kb < 4; ++kb) { a0[kb] = *(const LAS bf16x8*)(ldsK + r * KP_SB + (16 * kb + 8 * h) * 2); a1[kb] = *(const LAS bf16x8*)(ldsK + (32 + r) * KP_SB + (16 * kb + 8 * h) * 2); }
#pragma unroll
      for (int kb = 0; kb < 4; ++kb) { s0 = MFMA32(a0[kb], qf[kb], s0); s1 = MFMA32(a1[kb], qf[kb], s1); }
      __builtin_amdgcn_sched_group_barrier(0x100, 8, 0);
      __builtin_amdgcn_sched_group_barrier(0x008, 8, 0); }
    const int tq = q0 + r - 64 * j; const bool diag = (j == jmax);
    sb_subtile(s1, diag, tq, 32, h, carry);
    sb_subtile(s0, diag, tq, 0, h, carry);
#pragma unroll
    for (int sub = 0; sub < 2; ++sub)
#pragma unroll
        for (int s = 0; s < 2; ++s) {
            u32x4 pw;
            if (sub == 0) { pw.x = pk2(s0[8 * s], s0[8 * s + 1]); pw.y = pk2(s0[8 * s + 2], s0[8 * s + 3]); pw.z = pk2(s0[8 * s + 4], s0[8 * s + 5]); pw.w = pk2(s0[8 * s + 6], s0[8 * s + 7]); }
            else          { pw.x = pk2(s1[8 * s], s1[8 * s + 1]); pw.y = pk2(s1[8 * s + 2], s1[8 * s + 3]); pw.z = pk2(s1[8 * s + 4], s1[8 * s + 5]); pw.w = pk2(s1[8 * s + 6], s1[8 * s + 7]); }
            const bf16x8 pb = __builtin_bit_cast(bf16x8, pw);
            const int koff = (32 * sub + 16 * s + 4 * h) * 2;
            { const s16x4 lo = *(const LAS s16x4*)(ldsV + r * VP + koff), hi = *(const LAS s16x4*)(ldsV + r * VP + koff + 16);
              o0 = MFMA32(__builtin_shufflevector(lo, hi, 0, 1, 2, 3, 4, 5, 6, 7), pb, o0); }
            { const s16x4 lo = *(const LAS s16x4*)(ldsV + (32 + r) * VP + koff), hi = *(const LAS s16x4*)(ldsV + (32 + r) * VP + koff + 16);
              o1 = MFMA32(__builtin_shufflevector(lo, hi, 0, 1, 2, 3, 4, 5, 6, 7), pb, o1); }
        }
    return __builtin_amdgcn_ballot_w64(carry == 0.f) == ~0ull;
}
#ifndef SB_WIN_BACK
#define SB_WIN_BACK 3
#endif
constexpr int SBW = 18432, SB_FLAGS = 132096;
DI void sb_unit(LAS uchar* lds, const bf16* Qs, const bf16* Ks, const bf16* Vt, bf16* O, int bh, int qb, int tid, int wid, int lane) {
    asm volatile("" : "+v"(tid), "+v"(lane));
    const int b = bh >> 3, hd = bh & 7, r = lane & 31, h = lane >> 5;
    const size_t tbase = (size_t)b * SEQ;
    const int q0 = qb * 256 + wid * 32;
    const int jmax = 4 * qb + (wid >> 1), jlo = (4 * qb - SB_WIN_BACK > 0) ? 4 * qb - SB_WIN_BACK : 0, ntw = 4 * qb + 4 - jlo;
    { const char* kgb = (const char*)(Ks + tbase * 512 + hd * 64); const char* vgb = (const char*)(Vt + (size_t)bh * 64 * SEQ);
      for (int p = wid; p < 18 * ntw; p += 8) {
          const int tw = p / 18, q = p - 18 * tw, qi = q < 9 ? q : q - 9, s = 64 * qi + lane, row = s / 9, c0 = s - 9 * row, c = c0 < 8 ? c0 : 7, j = jlo + tw;
          const char* g = (q < 9) ? kgb + (size_t)(64 * j + row) * 1024 + c * 16 : vgb + ((size_t)row * SEQ + 64 * j) * 2 + c * 16;
          __builtin_amdgcn_global_load_lds((const unsigned*)g, (LAS unsigned*)(lds + tw * SBW + (q < 9 ? 0 : 9216) + 1024 * qi), 16, 0, 0);
      } }
    bf16x8 qf[4];
    { const bf16* qp = Qs + (tbase + q0 + r) * 512 + hd * 64 + 8 * h;
#pragma unroll
      for (int kb = 0; kb < 4; ++kb) qf[kb] = *(const bf16x8*)(qp + 16 * kb); }
    f32x16 o0, o1;
#pragma unroll
    for (int q = 0; q < 16; ++q) { o0[q] = 0.f; o1[q] = 0.f; }
    float carry = 1.0f;
    volatile LAS unsigned* flags = (volatile LAS unsigned*)(lds + SB_FLAGS);
    asm volatile("s_waitcnt vmcnt(0)" ::: "memory");
    LBAR();
    bool done = false;
    for (int j = jmax; j >= jlo && !done; --j) { LAS uchar* sl = lds + (j - jlo) * SBW; done = sb_compute(sl, sl + 9216, j, jmax, q0, r, h, qf, o0, o1, carry); }
    if (lane == 0) flags[16 + wid] = (!done && jlo > 0) ? 1u : 0u;
    LBAR();
    unsigned more = 0u;
#pragma unroll
    for (int w = 0; w < 8; ++w) more |= flags[16 + w];
    if (more) {
        const int ntg = jlo;
        const bf16* kg = Ks + (tbase + (tid >> 3)) * 512 + hd * 64 + (tid & 7) * 8;
        const bf16* vg = Vt + ((size_t)bh * 64 + (tid >> 3)) * SEQ + (tid & 7) * 8;
        struct KV2 { u32x4 ka, va; };
        KV2 R0, R1, R2;
        bool stop = false;
#define SB_LOAD(R, ii) do { const int jt_ = ntg - 1 - (ii); R.ka = *(const u32x4*)(kg + (size_t)(64 * jt_) * 512); R.va = *(const u32x4*)(vg + 64 * jt_); } while (0)
#define SB_STORE(R, bb) do { LAS uchar* kb_ = lds + (bb) * MLA_BUF; *(LAS u32x4*)(kb_ + (tid >> 3) * KP_SB + (tid & 7) * 16) = R.ka; *(LAS u32x4*)(kb_ + MLA_VOFF + (tid >> 3) * VP + (tid & 7) * 16) = R.va; } while (0)
#define SB_STEP(ii, R) do { const int i_ = (ii), j_ = ntg - 1 - i_; if (i_ + 1 < ntg) SB_STORE(R, (i_ + 1) & 1); if (i_ + 4 < ntg) SB_LOAD(R, i_ + 4); \
        if (!done && j_ <= jmax) { LAS uchar* kb2_ = lds + (i_ & 1) * MLA_BUF; done = sb_compute(kb2_, kb2_ + MLA_VOFF, j_, jmax, q0, r, h, qf, o0, o1, carry); } \
        if (lane == 0) flags[(i_ & 1) * 8 + wid] = done ? 1u : 0u; \
        LBAR(); \
        { unsigned all_ = 1u; _Pragma("unroll") for (int w_ = 0; w_ < 8; ++w_) all_ &= flags[(i_ & 1) * 8 + w_]; stop = all_ != 0u; } } while (0)
        SB_LOAD(R0, 0); if (ntg > 1) SB_LOAD(R1, 1); if (ntg > 2) SB_LOAD(R2, 2);
        SB_STORE(R0, 0); if (ntg > 3) SB_LOAD(R0, 3);
        LBAR();
        for (int i3 = 0; i3 < ntg; i3 += 3) {
            SB_STEP(i3, R1); if (stop || i3 + 1 >= ntg) break;
            SB_STEP(i3 + 1, R2); if (stop || i3 + 2 >= ntg) break;
            SB_STEP(i3 + 2, R0); if (stop) break;
        }
#undef SB_LOAD
#undef SB_STORE
#undef SB_STEP
    }
    LBAR();
    bf16* op = O + (tbase + q0 + r) * 512 + hd * 64 + 4 * h;
#pragma unroll
    for (int g = 0; g < 4; ++g) {
        u32x2 w0, w1; w0.x = pk2(o0[4 * g], o0[4 * g + 1]); w0.y = pk2(o0[4 * g + 2], o0[4 * g + 3]);
        w1.x = pk2(o1[4 * g], o1[4 * g + 1]); w1.y = pk2(o1[4 * g + 2], o1[4 * g + 3]);
        *(u32x2*)(op + 8 * g) = w0; *(u32x2*)(op + 32 + 8 * g) = w1;
    }
}

#define XB_TMO      128
#define XB_XCNT(j)  (256  + 64 * (j))
#define XB_XSUB(j)  (1280 + 64 * (j))
#define XB_XGEN(j)  (2304 + 64 * (j))
#define XB_TOP      3328
#define XB_TOPGEN   3392
#define XCD_BAR_WORDS 3456
#define XB_SPIN_CAP (1u << 18)

__device__ __forceinline__ unsigned xb_ld(unsigned* p)              { return __hip_atomic_load(p, __ATOMIC_RELAXED, __HIP_MEMORY_SCOPE_AGENT); }
__device__ __forceinline__ unsigned xb_add(unsigned* p, unsigned v) { return __hip_atomic_fetch_add(p, v, __ATOMIC_RELAXED, __HIP_MEMORY_SCOPE_AGENT); }
__device__ __forceinline__ unsigned xb_xcc_id() { return (unsigned)__builtin_amdgcn_s_getreg((3 << 11) | 20) & 0xFu; }
#define XB_SPIN(cond, bar) do { unsigned _sp = 0; while (cond) { __builtin_amdgcn_s_sleep(1); \
    if ((++_sp & 255u) == 0u) { if (xb_ld(&(bar)[XB_TMO])) break; if (_sp > XB_SPIN_CAP) { atomicAdd(&(bar)[XB_TMO], 1u); break; } } } } while (0)

struct XcdBarrier {
    unsigned* bar; unsigned x;
    volatile LAS unsigned* st;
};

__device__ __forceinline__ XcdBarrier xcd_barrier_post(unsigned* bar, volatile LAS unsigned* st, const bool is_t0) {
    XcdBarrier b; b.bar = bar; b.x = xb_xcc_id(); b.st = st;
    if (is_t0) (void)xb_add(&bar[XB_XCNT(b.x)], 1u);
    return b;
}
__device__ __forceinline__ void xcd_barrier_complete(unsigned* bar, unsigned x, unsigned& nloc, unsigned& nx) {
    const unsigned G = gridDim.x * gridDim.y * gridDim.z;
    unsigned sum, cnt, mine, sp = 0u;
    for (;;) {
        sum = 0u; cnt = 0u; mine = 0u;
#pragma unroll
        for (unsigned j = 0; j < 16; ++j) { const unsigned c = xb_ld(&bar[XB_XCNT(j)]); sum += c; cnt += (c > 0u) ? 1u : 0u; mine = (j == x) ? c : mine; }
        if (sum == G) break;
        __builtin_amdgcn_s_sleep(1);
        if ((++sp & 255u) == 0u) { if (xb_ld(&bar[XB_TMO])) break; if (sp > XB_SPIN_CAP) { atomicAdd(&bar[XB_TMO], 1u); break; } }
    }
    nloc = mine > 0u ? mine : 1u; nx = cnt > 0u ? cnt : 1u;
}

__device__ __forceinline__ void xcd_barrier(const XcdBarrier& b, const int wave_s) {
    unsigned z_ = 0u; asm volatile("" : "+v"(z_));
    const bool is_t0 = (wave_s == 0) && (__builtin_amdgcn_mbcnt_hi(~0u, __builtin_amdgcn_mbcnt_lo(~0u, z_)) == 0u);
    asm volatile("s_waitcnt vmcnt(0)" ::: "memory");
    __syncthreads();
    if (is_t0) {
        unsigned* bar = b.bar;
        __builtin_amdgcn_s_waitcnt(0);
        unsigned nloc = b.st[0], nx = b.st[1];
        if (nloc == 0u) { xcd_barrier_complete(bar, b.x, nloc, nx); b.st[0] = nloc; b.st[1] = nx; }
        const unsigned old = xb_add(&bar[XB_XSUB(b.x)], 1u);
        const unsigned gen = old / nloc;
        if (old + 1u == (gen + 1u) * nloc) {
            __builtin_amdgcn_fence(__ATOMIC_RELEASE, "agent");
            asm volatile("s_waitcnt vmcnt(0)" ::: "memory");
            const unsigned og = xb_add(&bar[XB_TOP], 1u);
            const unsigned tg = og / nx;
            if (og + 1u == (tg + 1u) * nx) xb_add(&bar[XB_TOPGEN], 1u);
            else XB_SPIN(xb_ld(&bar[XB_TOPGEN]) == tg, bar);
            __builtin_amdgcn_fence(__ATOMIC_ACQUIRE, "agent");
            xb_add(&bar[XB_XGEN(b.x)], 1u);
            asm volatile("s_waitcnt vmcnt(0)" ::: "memory");
        } else {
            XB_SPIN(xb_ld(&bar[XB_XGEN(b.x)]) == gen, bar);
            __builtin_amdgcn_fence(__ATOMIC_ACQUIRE, "agent");
            asm volatile("s_waitcnt vmcnt(0)" ::: "memory");
        }
    }
    __syncthreads();
}

__global__ void __launch_bounds__(512, 2) mega_fwd(Params P) {
    extern __shared__ __attribute__((aligned(16))) unsigned char lds_raw[];
    LAS uchar* lds = (LAS uchar*)lds_raw;
    cg::grid_group grid = cg::this_grid();
    const int wave_s = __builtin_amdgcn_readfirstlane(threadIdx.x >> 6);
    const int G = gridDim.x, NGW = G * 8, NT = G * 512;
#define FRESH() unsigned z_ = 0u; asm volatile("" : "+v"(z_)); const int tid = wave_s * 64 + (int)__builtin_amdgcn_mbcnt_hi(~0u, __builtin_amdgcn_mbcnt_lo(~0u, z_)); const int lane = tid & 63, wave = wave_s, gw = blockIdx.x * 8 + wave, gtid = blockIdx.x * 512 + tid; (void)lane; (void)gw; (void)gtid;
    unsigned char* ws = P.ws;
    const float* x = P.in[0];
    bf16* XN = (bf16*)(ws + WS_XN); float* H = (float*)(ws + WS_H); bf16* ACT = (bf16*)(ws + WS_ACT);
    bf16* CQ = (bf16*)(ws + WS_CQ); bf16* CKV = (bf16*)(ws + WS_CKV); float* KR = (float*)(ws + WS_KR);
    bf16* SBQ = (bf16*)(ws + WS_SBQ); bf16* SBK = (bf16*)(ws + WS_SBK); bf16* VTS = (bf16*)(ws + WS_VTS);
    bf16* QM = (bf16*)(ws + WS_QM); bf16* KM = (bf16*)(ws + WS_KM); bf16* VTM = (bf16*)(ws + WS_VTM);
    bf16* OM = (bf16*)(ws + WS_OM); bf16* OS = SBQ; bf16* MERGED = (bf16*)(ws + WS_MERGED); float* TMP = (float*)(ws + WS_TMP); bf16* PB = (bf16*)(ws + WS_PB);
    bf16* GATES = (bf16*)P.out;

#ifdef PROBE_A
    unsigned long long* tsbuf = (unsigned long long*)(ws + 900 * 1024); int n_stamp = 0;
#define STAMP() do { if (blockIdx.x == 0 && wave_s == 0 && __builtin_amdgcn_mbcnt_hi(~0u, __builtin_amdgcn_mbcnt_lo(~0u, 0u)) == 0u) tsbuf[n_stamp] = __builtin_amdgcn_s_memrealtime(); ++n_stamp; } while (0)
#else
#define STAMP() do {} while (0)
#endif
    STAMP();
    float* RS0 = (float*)(ws + WS_RS); float* RS1 = RS0 + T; float* RS2 = RS0 + 2 * T; float* RS3 = RS0 + 3 * T; float* RSQ = RS0 + 4 * T; float* RSKV = RS0 + 5 * T;
    bf16* HB2 = (bf16*)(ws + WS_HB2); bf16* HHI = (bf16*)(ws + WS_H); bf16* HLO = (bf16*)(ws + WS_H + 64 * MiB);
    unsigned* barw = (unsigned*)(ws + 904 * 1024);
    volatile LAS unsigned* bst = (volatile LAS unsigned*)(lds + 135168);
    if (threadIdx.x < 2) bst[threadIdx.x] = 0u;
    __syncthreads();
    if (P.ws == nullptr) grid.sync();
    const XcdBarrier xbar = xcd_barrier_post(barw, bst, wave_s == 0 && __builtin_amdgcn_mbcnt_hi(~0u, __builtin_amdgcn_mbcnt_lo(~0u, 0u)) == 0u);
    { FRESH(); for (int i = gtid; i < 5 * T / 4; i += NT) ((f32x4*)RS1)[i] = (f32x4){0.f, 0.f, 0.f, 0.f}; }
    { FRESH(); prep_weights(P, lds, gw, NGW, wave, lane, 0, NJOBS_EARLY); }
    { FRESH(); x_phase(x, XN, RS0, gw, NGW, lane); }
    xcd_barrier(xbar, wave_s); STAMP();
    { Epi<M_SWIGLU> E{}; E.o0 = ACT; E.rs = RS0; E.rsn = 1.f / 1024.f; run_gemm<M_SWIGLU>(lds, XN, (const bf16*)(ws + WS_FF1IN), T, 2 * FF, DM, E, wave_s); }
    xcd_barrier(xbar, wave_s); STAMP();
    { Epi<M_RESID_FP> E{}; E.o0 = HHI; E.o1 = HLO; E.i0 = x; E.alpha = 0.5f; E.rso = RS1; run_gemm<M_RESID_FP>(lds, ACT, (const bf16*)(ws + WS_FF1OUT), T, DM, FF, E, wave_s); }
    xcd_barrier(xbar, wave_s); STAMP();
    { Epi<M_INPROJ> E{}; E.o0 = CQ; E.o1 = CKV; E.o2 = KR; E.o3 = SBQ; E.o4 = SBK; E.o5 = GATES; E.rs = RS1; E.rsn = 1.f / 1024.f; E.rso = RSQ; E.pos = (const int*)P.in[2]; E.g2 = P.in[13];
      run_gemm<M_INPROJ>(lds, HHI, (const bf16*)(ws + WS_WIN), T, 3840, DM, E, wave_s); }
    { Epi<M_VT> E{}; E.o0 = VTS; E.rs = RS1; E.rsn = 1.f / 1024.f; run_gemm<M_VT>(lds, (const bf16*)(ws + WS_WSBV), HHI, 512, T, DM, E, wave_s); }
    xcd_barrier(xbar, wave_s); STAMP();
    { Epi<M_QUP> E{}; E.o0 = QM; E.rs = RSQ; E.rsn = 1.f / 384.f; run_gemm<M_QUP>(lds, CQ, (const bf16*)(ws + WS_WQ), T, 768, 384, E, wave_s); }
    { Epi<M_KNOPE> E{}; E.o0 = KM; E.rs = RSKV; E.rsn = 1.f / 256.f; E.rs2 = RSKV + T; E.i0 = KR; E.g2 = P.in[13]; run_gemm<M_KNOPE>(lds, CKV, (const bf16*)(ws + WS_WKN), T, 512, 256, E, wave_s); }
    { Epi<M_VT> E{}; E.o0 = VTM; E.rs = RSKV; E.rsn = 1.f / 256.f; run_gemm<M_VT>(lds, (const bf16*)(ws + WS_WV), CKV, 512, T, 256, E, wave_s); }
    xcd_barrier(xbar, wave_s); STAMP();
    const int vcu = (G % 8 == 0) ? ((int)blockIdx.x % 8) * (G / 8) + (int)blockIdx.x / 8 : (int)blockIdx.x;
    { for (int pp = vcu; pp < 1024; pp += G) { FRESH(); const int c = pp & 255, k = pp >> 8, bh = c >> 2, s = c & 3;
        const int qb = k == 0 ? 15 - s : (k == 1 ? 8 + s : (k == 2 ? 7 - s : s));
        mla_unit(lds, QM, KM, VTM, OM, (const int*)P.in[2], P.in[12], P.in[13], bh, qb, tid, wave, lane); } }
    STAMP();
    { for (int uu = vcu; uu < 1024; uu += G) { FRESH(); sb_unit(lds, SBQ, SBK, VTS, OS, uu >> 4, uu & 15, tid, wave, lane); } }
    __syncthreads();
    { FRESH(); prep_weights(P, lds, gw, NGW, wave, lane, NJOBS_EARLY, NJOBS - 1); }
    { FRESH(); cvt_phase(P.in[1], PB, (size_t)T * 256 / 8, (size_t)gtid, (size_t)NT); }
    __syncthreads();
    xcd_barrier(xbar, wave_s); STAMP();
    { Epi<M_DUAL> E{}; E.o0 = MERGED; E.i0 = GATES; run_gemm_dual(lds, OM, (const bf16*)(ws + WS_WBM), OS, (const bf16*)(ws + WS_WBS), T, DM, 512, E, wave_s); }
    xcd_barrier(xbar, wave_s); STAMP();
    { Epi<M_RESID_PP> E{}; E.o0 = HB2; E.o1 = HLO; E.i0 = HHI; E.i1 = HLO; E.alpha = 1.0f; E.rso = RS2; run_gemm<M_RESID_PP>(lds, MERGED, (const bf16*)(ws + WS_WOUT), T, DM, DM, E, wave_s); }
    xcd_barrier(xbar, wave_s); STAMP();
    { Epi<M_SWIGLU> E{}; E.o0 = ACT; E.rs = RS2; E.rsn = 1.f / 1024.f; run_gemm<M_SWIGLU>(lds, HB2, (const bf16*)(ws + WS_FF2IN), T, 2 * FF, DM, E, wave_s); }
    xcd_barrier(xbar, wave_s); STAMP();
    { Epi<M_RESID_PP> E{}; E.o0 = XN; E.o1 = HLO; E.i0 = HB2; E.i1 = HLO; E.alpha = 0.5f; E.rso = RS3; run_gemm<M_RESID_PP>(lds, ACT, (const bf16*)(ws + WS_FF2OUT), T, DM, FF, E, wave_s); }
    xcd_barrier(xbar, wave_s); STAMP();
    { Epi<M_SIGM> E{}; E.o0 = TMP; E.rs = RS3; E.rsn = 1.f / 1024.f; run_gemm<M_SIGM>(lds, XN, (const bf16*)(ws + WS_WG), T, DM, DM, E, wave_s); }
    { Epi<M_FINAL> E{}; E.o0 = P.out; E.i0 = XN; E.o1 = HLO; E.i1 = TMP; run_gemm<M_FINAL>(lds, PB, (const bf16*)(ws + WS_WP), T, DM, 256, E, wave_s); }
#ifdef PROBE_A
    xcd_barrier(xbar, wave_s); STAMP();
    xcd_barrier(xbar, wave_s); STAMP();
    { const float pa = (float)(tsbuf[PROBE_B] - tsbuf[PROBE_A]) * 0.0001f, pb = (float)(tsbuf[PROBE_D] - tsbuf[PROBE_C]) * 0.000001f;
      FRESH();
      if (gtid == 0) P.out[0] += pa;
      for (int i = gtid; i < 4 * 1024 * 1024; i += NT) P.out[(size_t)4096 * 1024 + i] += pb; }
#endif
}

extern "C" void kernel_launch(void* const* d_in, const int* in_sizes, int n_in, void* d_out, int out_size, void* d_ws, size_t ws_size, hipStream_t stream) {
    static int grid = 0;
    if (grid == 0) {
        if (n_in != 23 || ws_size < WS_END) { fprintf(stderr, "kernel_launch: unexpected n_in %d / ws_size %zu\n", n_in, ws_size); grid = -1; return; }
        int dev = 0, cus = 0, per_cu = 0;
        hipGetDevice(&dev); hipDeviceGetAttribute(&cus, hipDeviceAttributeMultiprocessorCount, dev);
        if (hipFuncSetAttribute((const void*)mega_fwd, hipFuncAttributeMaxDynamicSharedMemorySize, LDS_BYTES) != hipSuccess) { fprintf(stderr, "hipFuncSetAttribute failed\n"); grid = -1; return; }
        if (hipOccupancyMaxActiveBlocksPerMultiprocessor(&per_cu, (const void*)mega_fwd, 512, LDS_BYTES) != hipSuccess || per_cu < 1) { fprintf(stderr, "occupancy query: %d\n", per_cu); per_cu = 1; }
        (void)hipGetLastError();
        grid = cus * per_cu;
    }
    if (grid < 0) return;
    Params p{};
    for (int i = 0; i < 23; ++i) p.in[i] = (const float*)d_in[i];
    p.out = (float*)d_out; p.ws = (unsigned char*)d_ws;
    if (hipMemsetAsync((char*)d_ws + 904 * 1024, 0, XCD_BAR_WORDS * sizeof(unsigned), stream) != hipSuccess) { fprintf(stderr, "kernel_launch: hipMemsetAsync of the barrier words failed\n"); return; }
    void* args[] = {&p};
    hipError_t e = hipLaunchCooperativeKernel((const void*)mega_fwd, dim3(grid), dim3(512), args, LDS_BYTES, stream);
    if (e != hipSuccess) fprintf(stderr, "cooperative launch failed: %s (grid %d)\n", hipGetErrorString(e), grid);
}
```

```cpp
#include <hip/hip_runtime.h>
#include <hip/hip_cooperative_groups.h>
#include <cstdio>
#include <cstdint>
namespace cg = cooperative_groups;
namespace pg8 {
#define PG8_LAS __attribute__((address_space(3)))
typedef unsigned short bf16_t;
typedef short bf16x8 __attribute__((ext_vector_type(8)));
typedef float f32x4 __attribute__((ext_vector_type(4)));
typedef unsigned u32x4 __attribute__((ext_vector_type(4)));
constexpr int BM = 256, BK = 64, HALF = 128, HTB = HALF * BK * 2  , STAGE_BYTES = 8 * HTB, NXCD = 8, WGM = 8;

__host__ __device__ __forceinline__ int lds_byte(int r, int c) { const int st = (r >> 4) * 2 + (c >> 5), rr = r & 15, cc = c & 31, ob = rr * 64 + cc * 2; return st * 1024 + (ob ^ (((ob >> 9) & 1) << 5)); }
__host__ __device__ __forceinline__ void stage_rc(int b, int& R, int& C) { const int st = b / 1024, sb = b % 1024, swz = sb ^ (((sb >> 9) & 1) << 5); R = (st >> 1) * 16 + swz / 64; C = (st & 1) * 32 + (swz % 64) / 2; }
__host__ __device__ __forceinline__ int perm32(int rho) { const int n = rho >> 4, i = rho & 15; return 8 * (i >> 2) + 4 * n + (i & 3); }

struct Unit { int pm, pn, half; };
struct Gemm { const bf16_t* A; const bf16_t* Bt; int M, N, K; const bf16_t* A2; const bf16_t* Bt2; };

struct StaticOrder {
    int nM, nN, nwg, G, c;
    __host__ __device__ void init(int M, int N, int G_, int c_) { nM = M / BM; nN = N / BM; nwg = nM * nN; G = G_; c = c_; }
    __host__ __device__ bool next(int i, Unit& u) const {
        const long L = (long)i * G + c; if (L >= nwg) return false;
        int wgid = (int)L; { const int q = nwg / NXCD, r = nwg % NXCD, xcd = wgid % NXCD, off = wgid / NXCD; wgid = (xcd < r ? xcd * (q + 1) : r * (q + 1) + (xcd - r) * q) + off; }
        const int nig = WGM * nN, gid = wgid / nig, fm = gid * WGM, gsz = (nM - fm) < WGM ? (nM - fm) : WGM;
        u.pm = fm + ((wgid % nig) % gsz); u.pn = (wgid % nig) / gsz; u.half = 0; return true;
    }
    __device__ __forceinline__ void a_ready(const Unit&) const {}
    __device__ __forceinline__ void done(const Unit&) const {}
};

__device__ __forceinline__ unsigned cvt_pk_bf16(float lo, float hi) { unsigned r; asm volatile("v_cvt_pk_bf16_f32 %0, %1, %2" : "=v"(r) : "v"(lo), "v"(hi)); return r; }
typedef float f32x2 __attribute__((ext_vector_type(2)));
template <class Epi, class Sched, bool ALIGN_EPI = false, bool SP2 = false>
__device__ __forceinline__ void gemm_phase(PG8_LAS unsigned char* lds, const Gemm g, const Sched& S, const Epi& E, const int wave_s) {
    unsigned z_ = 0u; asm volatile("" : "+v"(z_)); int tid_ = wave_s * 64 + (int)__builtin_amdgcn_mbcnt_hi(~0u, __builtin_amdgcn_mbcnt_lo(~0u, z_)); const int tid = tid_, wid = __builtin_amdgcn_readfirstlane(tid >> 6), lane = tid & 63, wr = wid >> 2, wc = wid & 3, fr = lane & 15, fq = lane >> 4;
    const int K = g.K, nt = K / BK;
    unsigned voffA[2], voffB[2];
#pragma unroll
    for (int i = 0; i < 2; ++i) { int R, C; stage_rc(tid * 16 + i * 8192, R, C); const int Rb = Epi::PERM ? ((R & ~31) + perm32(R & 31)) : R;
        voffA[i] = (unsigned)(R * K + C) * 2u; voffB[i] = (unsigned)(Rb * K + C) * 2u; }
    const size_t kstep = (size_t)(BK * 2);
    const size_t hstep = (size_t)HALF * K * 2;
    const size_t tstep = 2 * hstep;
    const unsigned ldsw = (unsigned)wid * 1024u;
    const int aoff = lds_byte(wr * 64 + fr, fq * 8), boff = lds_byte(wc * 32 + fr, fq * 8);
#define PG8_SA(b, h) (((b) * 2 + (h)) * HTB)
#define PG8_SB(b, h) ((4 + (b) * 2 + (h)) * HTB)
#define PG8_STAGE(bufoff, gbase, voff) do { _Pragma("unroll") for (int _i = 0; _i < 2; ++_i) \
        __builtin_amdgcn_global_load_lds((const unsigned*)((const char*)(gbase) + (voff)[_i]), (PG8_LAS unsigned*)(lds + (bufoff) + ldsw + _i * 8192), 16, 0, 0); } while (0)
#define PG8_LDA(dst, b, h) do { _Pragma("unroll") for (int m = 0; m < 4; ++m) _Pragma("unroll") for (int k = 0; k < 2; ++k) dst[m][k] = *(const PG8_LAS bf16x8*)(lds + PG8_SA(b, h) + aoff + m * 2048 + k * 1024); } while (0)
#define PG8_LDB(dst, b, h) do { _Pragma("unroll") for (int n = 0; n < 2; ++n) _Pragma("unroll") for (int k = 0; k < 2; ++k) dst[n][k] = *(const PG8_LAS bf16x8*)(lds + PG8_SB(b, h) + boff + n * 2048 + k * 1024); } while (0)
#define PG8_MMA(ai, bj, At, Bt) do { __builtin_amdgcn_s_setprio(1); _Pragma("unroll") for (int m = 0; m < 4; ++m) _Pragma("unroll") for (int n = 0; n < 2; ++n) _Pragma("unroll") for (int k = 0; k < 2; ++k) \
        acc[ai][bj][m][n] = __builtin_amdgcn_mfma_f32_16x16x32_bf16(Bt[n][k], At[m][k], acc[ai][bj][m][n], 0, 0, 0); __builtin_amdgcn_s_setprio(0); } while (0)
#define PG8_WAIT_V(n) asm volatile("s_waitcnt vmcnt(" #n ")" ::: "memory")
#define PG8_WAIT_L(n) asm volatile("s_waitcnt lgkmcnt(" #n ")" ::: "memory")
#define PG8_BAR __builtin_amdgcn_s_barrier()
#define PG8_SCHED __builtin_amdgcn_sched_barrier(0)
    Unit cur, nxt; int ui = 0;
    if (!S.next(0, cur)) return;
    f32x4 acc[2][2][4][2];
#pragma unroll
    for (int a = 0; a < 2; ++a)
#pragma unroll
        for (int b = 0; b < 2; ++b)
#pragma unroll
            for (int m = 0; m < 4; ++m)
#pragma unroll
                for (int n = 0; n < 2; ++n) acc[a][b][m][n] = (f32x4){0.f, 0.f, 0.f, 0.f};
    bf16x8 At[4][2], B0[2][2], B1[2][2];
    const char* cA = (const char*)(cur.half ? g.A2 : g.A) + (size_t)cur.pm * tstep; const char* cB = (const char*)(cur.half ? g.Bt2 : g.Bt) + (size_t)cur.pn * tstep;
    S.a_ready(cur);
    if constexpr (SP2) {
        PG8_STAGE(PG8_SB(0, 0), cB, voffB); PG8_STAGE(PG8_SB(0, 1), cB + hstep, voffB); PG8_STAGE(PG8_SA(0, 0), cA, voffA); PG8_STAGE(PG8_SA(0, 1), cA + hstep, voffA);
        if (wr == 1) PG8_BAR;
        PG8_WAIT_V(2); PG8_BAR;
        PG8_STAGE(PG8_SB(1, 0), cB + kstep, voffB); PG8_STAGE(PG8_SA(1, 0), cA + kstep, voffA); PG8_STAGE(PG8_SB(1, 1), cB + hstep + kstep, voffB);
        PG8_WAIT_V(6); PG8_BAR;
    } else {
        PG8_STAGE(PG8_SB(0, 0), cB, voffB); PG8_STAGE(PG8_SA(0, 0), cA, voffA); PG8_STAGE(PG8_SB(0, 1), cB + hstep, voffB); PG8_STAGE(PG8_SA(0, 1), cA + hstep, voffA);
        if (wr == 1) PG8_BAR;
        PG8_WAIT_V(4); PG8_BAR;
        PG8_STAGE(PG8_SB(1, 0), cB + kstep, voffB); PG8_STAGE(PG8_SA(1, 0), cA + kstep, voffA); PG8_STAGE(PG8_SB(1, 1), cB + hstep + kstep, voffB);
        PG8_WAIT_V(6); PG8_BAR;
    }
    for (;;) {
        const bool has_next = S.next(ui + 1, nxt);
        const char* nA = has_next ? (const char*)(nxt.half ? g.A2 : g.A) + (size_t)nxt.pm * tstep : cA; const char* nB = has_next ? (const char*)(nxt.half ? g.Bt2 : g.Bt) + (size_t)nxt.pn * tstep : cB;
        for (int t = 0; t < nt; t += 2) {
            const bool last = (t == nt - 2);
            const char* a1 = cA + (size_t)(t + 1) * kstep;
            const char* a2 = last ? nA : cA + (size_t)(t + 2) * kstep; const char* b2 = last ? nB : cB + (size_t)(t + 2) * kstep;
            const char* a3 = a2 + kstep; const char* b3 = b2 + kstep;
            if (last && has_next) S.a_ready(nxt);
            if constexpr (SP2) {
            PG8_LDB(B0, 0, 0); PG8_LDB(B1, 0, 1); PG8_SCHED; PG8_LDA(At, 0, 0); PG8_STAGE(PG8_SA(1, 1), a1 + hstep, voffA);
            PG8_WAIT_V(8); PG8_WAIT_L(0); PG8_BAR; PG8_MMA(0, 0, At, B0); PG8_MMA(0, 1, At, B1); PG8_BAR; PG8_SCHED;
            PG8_LDA(At, 0, 1); PG8_STAGE(PG8_SB(0, 0), b2, voffB); PG8_STAGE(PG8_SB(0, 1), b2 + hstep, voffB); PG8_STAGE(PG8_SA(0, 0), a2, voffA);
            PG8_WAIT_V(8); PG8_WAIT_L(0); PG8_BAR; PG8_MMA(1, 0, At, B0); PG8_MMA(1, 1, At, B1); PG8_BAR; PG8_SCHED;
            PG8_LDB(B0, 1, 0); PG8_LDB(B1, 1, 1); PG8_SCHED; PG8_LDA(At, 1, 0); PG8_STAGE(PG8_SA(0, 1), a2 + hstep, voffA);
            PG8_WAIT_V(8); PG8_WAIT_L(0); PG8_BAR; PG8_MMA(0, 0, At, B0); PG8_MMA(0, 1, At, B1); PG8_BAR; PG8_SCHED;
            PG8_LDA(At, 1, 1); PG8_STAGE(PG8_SB(1, 0), b3, voffB); PG8_STAGE(PG8_SB(1, 1), b3 + hstep, voffB); PG8_STAGE(PG8_SA(1, 0), a3, voffA);
            PG8_WAIT_V(8); PG8_WAIT_L(0); PG8_BAR; PG8_MMA(1, 0, At, B0); PG8_MMA(1, 1, At, B1); PG8_BAR; PG8_SCHED;
            } else {
            PG8_LDB(B0, 0, 0); PG8_SCHED; PG8_LDA(At, 0, 0); PG8_STAGE(PG8_SA(1, 1), a1 + hstep, voffA);
            PG8_WAIT_L(8); PG8_BAR; PG8_WAIT_L(0); PG8_MMA(0, 0, At, B0); PG8_BAR; PG8_SCHED;
            PG8_LDB(B1, 0, 1); PG8_STAGE(PG8_SB(0, 0), b2, voffB);
            PG8_BAR; PG8_WAIT_L(0); PG8_MMA(0, 1, At, B1); PG8_BAR;
            PG8_LDA(At, 0, 1); PG8_STAGE(PG8_SA(0, 0), a2, voffA);
            PG8_BAR; PG8_WAIT_L(0); PG8_MMA(1, 0, At, B0); PG8_BAR; PG8_SCHED;
            PG8_STAGE(PG8_SB(0, 1), b2 + hstep, voffB);
            PG8_WAIT_V(6); PG8_BAR; PG8_MMA(1, 1, At, B1); PG8_BAR;
            PG8_LDB(B0, 1, 0); PG8_SCHED; PG8_LDA(At, 1, 0); PG8_STAGE(PG8_SA(0, 1), a2 + hstep, voffA);
            PG8_WAIT_L(8); PG8_BAR; PG8_WAIT_L(0); PG8_MMA(0, 0, At, B0); PG8_BAR; PG8_SCHED;
            PG8_LDB(B1, 1, 1); PG8_STAGE(PG8_SB(1, 0), b3, voffB);
            PG8_BAR; PG8_WAIT_L(0); PG8_MMA(0, 1, At, B1); PG8_BAR;
            PG8_LDA(At, 1, 1); PG8_STAGE(PG8_SA(1, 0), a3, voffA);
            PG8_BAR; PG8_WAIT_L(0); PG8_MMA(1, 0, At, B0); PG8_BAR; PG8_SCHED;
            PG8_STAGE(PG8_SB(1, 1), b3 + hstep, voffB);
            PG8_WAIT_V(6); PG8_BAR; PG8_MMA(1, 1, At, B1); PG8_BAR;
            }
        }
        if constexpr (ALIGN_EPI) { if (wr == 0) PG8_BAR; }
        if constexpr (!Epi::AFTER_DRAIN) { E(acc, cur, wr, wc, fr, fq); S.done(cur); }
        if (!has_next) break;
        if (E.zero_after(cur))
#pragma unroll
        for (int a = 0; a < 2; ++a)
#pragma unroll
            for (int b = 0; b < 2; ++b)
#pragma unroll
                for (int m = 0; m < 4; ++m)
#pragma unroll
                    for (int n = 0; n < 2; ++n) acc[a][b][m][n] = (f32x4){0.f, 0.f, 0.f, 0.f};
        cur = nxt; cA = nA; cB = nB; ++ui;
        if constexpr (ALIGN_EPI) { if (wr == 1) PG8_BAR; }
    }
    PG8_WAIT_V(0);
    if constexpr (!ALIGN_EPI) { if (wr == 0) PG8_BAR; }
    PG8_BAR;
    if constexpr (Epi::AFTER_DRAIN) { E.fused(acc, cur, wr, wc, fr, fq, lds, wid, lane); S.done(cur); }
#undef PG8_SA
#undef PG8_SB
#undef PG8_STAGE
#undef PG8_LDA
#undef PG8_LDB
#undef PG8_MMA
#undef PG8_WAIT_V
#undef PG8_WAIT_L
#undef PG8_BAR
#undef PG8_SCHED
}
}
#ifndef PG8_SP2
#define PG8_SP2 true
#endif
#ifndef PG8_ALIGN
#define PG8_ALIGN true
#endif

#define LAS __attribute__((address_space(3)))
typedef unsigned char uchar;
typedef unsigned short bf16;
typedef unsigned u32x4 __attribute__((ext_vector_type(4)));
typedef unsigned u32x2 __attribute__((ext_vector_type(2)));
typedef float f32x4 __attribute__((ext_vector_type(4)));
typedef float f32x2 __attribute__((ext_vector_type(2)));
typedef float f32x16 __attribute__((ext_vector_type(16)));
typedef short bf16x8 __attribute__((ext_vector_type(8)));
typedef short s16x4 __attribute__((ext_vector_type(4)));
typedef __bf16 bf16x2_t __attribute__((ext_vector_type(2)));
#define DI __device__ __forceinline__
#define MFMA32(a, b, c) __builtin_amdgcn_mfma_f32_32x32x16_bf16((a), (b), (c), 0, 0, 0)

DI unsigned pk2(float a, float b) { f32x2 v = {a, b}; return __builtin_bit_cast(unsigned, __builtin_convertvector(v, bf16x2_t)); }
DI float bf_lo(unsigned u) { return __uint_as_float(u << 16); }
DI float bf_hi(unsigned u) { return __uint_as_float(u & 0xffff0000u); }
DI u32x4 pack8(f32x4 a, f32x4 b) { u32x4 w; w.x = pk2(a[0], a[1]); w.y = pk2(a[2], a[3]); w.z = pk2(b[0], b[1]); w.w = pk2(b[2], b[3]); return w; }
DI float sigmoidf_(float v) { return __builtin_amdgcn_rcpf(1.0f + __builtin_amdgcn_exp2f(-1.44269504089f * v)); }
DI float wave_sum(float v) {
#pragma unroll
    for (int o = 1; o < 64; o <<= 1) v += __shfl_xor(v, o);
    return v;
}

constexpr int T = 32768, DM = 1024, FF = 2816, SEQ = 4096;
constexpr float NORM_EPS = 1e-6f;
constexpr float LOG2E = 1.44269504089f;
constexpr float QSCALE_MLA = 0.10206207261596577f * 1.44269504089f;
constexpr float QSCALE_SB = 0.125f * 1.44269504089f;
constexpr size_t MiB = 1u << 20;
constexpr size_t WS_FF1IN = 1 * MiB, WS_FF1OUT = 12 * MiB, WS_FF2IN = 18 * MiB, WS_FF2OUT = 29 * MiB, WS_WIN = 35 * MiB, WS_WSBV = 43 * MiB,
                 WS_WQ = 44 * MiB, WS_WKN = 45 * MiB, WS_WV = 45 * MiB + 512 * 1024, WS_WBM = 46 * MiB, WS_WBS = 47 * MiB, WS_WOUT = 48 * MiB,
                 WS_WG = 50 * MiB, WS_WP = 52 * MiB;
constexpr size_t WS_XN = 54 * MiB, WS_H = 118 * MiB, WS_BIG = 246 * MiB;
constexpr size_t WS_KM = WS_XN, WS_MERGED = WS_XN;
constexpr size_t WS_ACT = WS_BIG, WS_CQ = WS_BIG, WS_CKV = WS_BIG + 24 * MiB, WS_OM = WS_BIG, WS_SBQ = WS_BIG + 40 * MiB, WS_SBK = WS_BIG + 72 * MiB,
                 WS_VTS = WS_BIG + 104 * MiB, WS_QM = WS_BIG + 136 * MiB, WS_VTM = WS_BIG + 184 * MiB, WS_KR = WS_BIG + 216 * MiB,
                 WS_TMP = WS_BIG + 72 * MiB, WS_HB2 = WS_BIG + 176 * MiB, WS_PB = WS_BIG + 240 * MiB, WS_END = WS_BIG + 256 * MiB;
constexpr size_t WS_RS = 0;
constexpr int LDS_BYTES = 147456;

struct Params { const float* in[23]; float* out; unsigned char* ws; };

struct Job { int src, K, Nsrc, Ndst, mode, off; unsigned long long dst; int gain, pad; };
constexpr int NJOBS = 15, NJOBS_EARLY = 7;
__constant__ Job c_jobs[NJOBS] = {
    {4, 1024, 5632, 5632, 1, 0, WS_FF1IN, 3, 0},   {5, 2816, 1024, 1024, 0, 0, WS_FF1OUT, -1, 0}, {7, 1024, 4256, 3840, 5, 0, WS_WIN, 6, 0},     {7, 1024, 4256, 512, 0, 1696, WS_WSBV, 6, 0},
    {9, 384, 768, 768, 0, 0, WS_WQ, 8, 0},         {11, 256, 1024, 512, 6, 0, WS_WKN, 10, 0},     {11, 256, 1024, 512, 3, 64, WS_WV, 10, 0},
    {18, 1024, 5632, 5632, 1, 0, WS_FF2IN, 17, 0}, {19, 2816, 1024, 1024, 0, 0, WS_FF2OUT, -1, 0}, {14, 512, 1024, 1024, 0, 0, WS_WBM, -1, 0},   {15, 512, 1024, 1024, 0, 0, WS_WBS, -1, 0},
    {16, 1024, 1024, 1024, 0, 0, WS_WOUT, -1, 0},  {21, 1024, 1024, 1024, 0, 0, WS_WG, 20, 0},    {22, 256, 1024, 1024, 0, 0, WS_WP, -1, 0},    {0, 0, 0, 0, 0, 0, 0, -1, 0}};
__constant__ float c_invf[16] = {1.0f, 0.5623413251903491f, 0.31622776601683794f, 0.1778279410038923f, 0.1f, 0.05623413251903491f, 0.03162277660168379f, 0.01778279410038923f,
                                 0.01f, 0.005623413251903491f, 0.0031622776601683794f, 0.001778279410038923f, 0.001f, 0.0005623413251903491f, 0.00031622776601683794f, 0.0001778279410038923f};

DI int map_col(int mode, int n0, int off) {
    if (mode == 0) return n0 + off;
    if (mode == 1) { const int pn = n0 >> 8, half = (n0 >> 7) & 1, j = n0 & 127; return half * FF + pn * 128 + j; }
    if (mode == 2) { const int h = n0 >> 7, j = n0 & 127; return j < 96 ? h * 96 + j : -1; }
    if (mode == 3) { const int h = n0 >> 6, j = n0 & 63; return h * 128 + j + off; }
    if (mode == 6) { const int pn = n0 >> 8, bj = (n0 >> 7) & 1, wc = (n0 >> 5) & 3; return 128 * (4 * pn + wc) + 32 * bj; }
    if (n0 < 672) return n0;
    if (n0 < 768) return -1;
    if (n0 < 1792) return n0 - 96;
    { const int g = n0 - 1792, gt = g >> 8, bj = (g >> 7) & 1; return 2208 + bj * 1024 + gt * 128 + (g & 127); }
}

struct TItem { const float* W; const float* gain; bf16* WT; int K, Nsrc, n0, sc, k0; };
DI void titem_decode(const Params& P, int it, TItem& t, int jlo, int jhi) {
    int r = it, j = jlo;
    for (; j < jhi; ++j) { const int n = (c_jobs[j].K >> 6) * (c_jobs[j].Ndst >> 5); if (r < n) break; r -= n; }
    const int nblk = c_jobs[j].Ndst >> 5, kb = r / nblk, nb = r % nblk;
    t.K = c_jobs[j].K; t.Nsrc = c_jobs[j].Nsrc; t.n0 = nb * 32; t.k0 = kb * 64; t.sc = map_col(c_jobs[j].mode, t.n0, c_jobs[j].off);
    t.W = P.in[c_jobs[j].src]; const int gi = c_jobs[j].gain; t.gain = gi >= 0 ? P.in[gi] : nullptr; t.WT = (bf16*)(P.ws + c_jobs[j].dst);
}
DI void titem_load(const TItem& t, f32x4 (&v)[8], float (&g)[8], int lane) {
#pragma unroll
    for (int i = 0; i < 8; ++i) { const int kk = (lane >> 3) + 8 * i;
        v[i] = (t.sc >= 0) ? *(const f32x4*)(t.W + (size_t)(t.k0 + kk) * t.Nsrc + t.sc + 4 * (lane & 7)) : (f32x4){0.f, 0.f, 0.f, 0.f};
        g[i] = t.gain ? t.gain[t.k0 + kk] : 1.0f; }
}
DI void titem_finish(const TItem& t, const f32x4 (&v)[8], const float (&g)[8], LAS float* scr, int lane) {
#pragma unroll
    for (int i = 0; i < 8; ++i) { const int kk = (lane >> 3) + 8 * i; LAS float* s = scr + kk * 33 + 4 * (lane & 7);
        s[0] = v[i][0] * g[i]; s[1] = v[i][1] * g[i]; s[2] = v[i][2] * g[i]; s[3] = v[i][3] * g[i]; }
    asm volatile("s_waitcnt lgkmcnt(0)" ::: "memory");
    const int c = lane & 7;
#pragma unroll
    for (int j = 0; j < 4; ++j) { const int n = (lane >> 3) + 8 * j; const LAS float* s = scr + (8 * c) * 33 + n;
        u32x4 o; o.x = pk2(s[0 * 33], s[1 * 33]); o.y = pk2(s[2 * 33], s[3 * 33]); o.z = pk2(s[4 * 33], s[5 * 33]); o.w = pk2(s[6 * 33], s[7 * 33]);
        *(u32x4*)(t.WT + (size_t)(t.n0 + n) * t.K + t.k0 + 8 * c) = o; }
    asm volatile("s_waitcnt lgkmcnt(0)" ::: "memory");
}
DI void prep_weights(const Params& P, LAS uchar* lds, int gw, int NGW, int wave, int lane, int jlo, int jhi) {
    LAS float* scr = (LAS float*)(lds + wave * 16384);
    int total = 0;
    for (int j = jlo; j < jhi; ++j) total += (c_jobs[j].K >> 6) * (c_jobs[j].Ndst >> 5);
    if (gw >= total) return;
    TItem cur, nxt; f32x4 va[8], vb[8]; float ga[8], gb[8];
    titem_decode(P, gw, cur, jlo, jhi); titem_load(cur, va, ga, lane);
    for (int it = gw; it < total; it += 2 * NGW) {
        const bool h1 = it + NGW < total, h2 = it + 2 * NGW < total;
        if (h1) { titem_decode(P, it + NGW, nxt, jlo, jhi); titem_load(nxt, vb, gb, lane); }
        titem_finish(cur, va, ga, scr, lane);
        if (h2) { titem_decode(P, it + 2 * NGW, cur, jlo, jhi); titem_load(cur, va, ga, lane); }
        if (h1) titem_finish(nxt, vb, gb, scr, lane);
    }
}

DI void rms_row_1024(const float* xrow, const float* gain, bf16* orow, int lane) {
    const f32x4* xr = (const f32x4*)xrow + lane;
    f32x4 v[4]; float s = 0.f;
#pragma unroll
    for (int j = 0; j < 4; ++j) { v[j] = xr[64 * j]; s += (v[j].x * v[j].x + v[j].y * v[j].y) + (v[j].z * v[j].z + v[j].w * v[j].w); }
    const float r = 1.0f / sqrtf(wave_sum(s) * (1.f / 1024.f) + NORM_EPS);
    u32x2* o8 = (u32x2*)orow + lane;
#pragma unroll
    for (int j = 0; j < 4; ++j) { const f32x4 g = ((const f32x4*)gain)[64 * j + lane]; u32x2 w; w.x = pk2((v[j].x * r) * g.x, (v[j].y * r) * g.y); w.y = pk2((v[j].z * r) * g.z, (v[j].w * r) * g.w); o8[64 * j] = w; }
}
DI void norm_phase(const float* X, const float* gain, bf16* O, int gw, int NGW, int lane) {
    for (int m = gw; m < T; m += NGW) rms_row_1024(X + (size_t)m * DM, gain, O + (size_t)m * DM, lane);
}
template <int NJ> DI void latent_norm_phase(bf16* X, const float* gain, int gw, int NGW, int lane) {
    for (int m = gw; m < T; m += NGW) {
        unsigned* row = (unsigned*)(X + (size_t)m * (128 * NJ)) + lane;
        unsigned u[NJ]; float s = 0.f;
#pragma unroll
        for (int j = 0; j < NJ; ++j) { u[j] = row[64 * j]; const float a = bf_lo(u[j]), b = bf_hi(u[j]); s += a * a + b * b; }
        const float r = 1.0f / sqrtf(wave_sum(s) * (1.f / (128.f * NJ)) + NORM_EPS);
#pragma unroll
        for (int j = 0; j < NJ; ++j) { const f32x2 g = ((const f32x2*)gain)[64 * j + lane]; row[64 * j] = pk2((bf_lo(u[j]) * r) * g.x, (bf_hi(u[j]) * r) * g.y); }
    }
}
DI void x_phase(const float* X, bf16* O, float* RS, int gw, int NGW, int lane) {
    for (int m = gw; m < T; m += 4 * NGW) {
        f32x4 v[4][4];
#pragma unroll
        for (int q = 0; q < 4; ++q) { const int mq = (m + q * NGW < T) ? m + q * NGW : m; const f32x4* xr = (const f32x4*)(X + (size_t)mq * DM) + lane;
#pragma unroll
            for (int j = 0; j < 4; ++j) v[q][j] = xr[64 * j]; }
#pragma unroll
        for (int q = 0; q < 4; ++q) { const int mq = m + q * NGW;
            if (mq < T) { float s = 0.f;
#pragma unroll
                for (int j = 0; j < 4; ++j) s += (v[q][j].x * v[q][j].x + v[q][j].y * v[q][j].y) + (v[q][j].z * v[q][j].z + v[q][j].w * v[q][j].w);
                s = wave_sum(s);
                u32x2* o = (u32x2*)(O + (size_t)mq * DM) + lane;
#pragma unroll
                for (int j = 0; j < 4; ++j) { u32x2 w; w.x = pk2(v[q][j].x, v[q][j].y); w.y = pk2(v[q][j].z, v[q][j].w); o[64 * j] = w; }
                if (lane == 0) RS[mq] = s; } }
    }
}
DI void cvt_phase(const float* X, bf16* O, size_t n8, size_t gtid, size_t NT) {
    for (size_t i = gtid; i < n8; i += 4 * NT) {
        f32x4 a[4], b[4];
#pragma unroll
        for (int q = 0; q < 4; ++q) { const size_t iq = (i + q * NT < n8) ? i + q * NT : i; a[q] = ((const f32x4*)X)[2 * iq]; b[q] = ((const f32x4*)X)[2 * iq + 1]; }
#pragma unroll
        for (int q = 0; q < 4; ++q) if (i + q * NT < n8) ((u32x4*)O)[i + q * NT] = pack8(a[q], b[q]);
    }
}

DI void qk_phase(bf16* Qm, bf16* Km, const float* KR, const int* positions, const float* gq, const float* gk, int gtid, int NT) {
    for (int it = gtid; it < 2 * T * 8; it += NT) {
        const bool isk = it >= T * 8; const int e = isk ? it - T * 8 : it; const int t = e >> 3;
        bf16* base = (isk ? Km : Qm) + (size_t)e * 96;
        float v[96];
#pragma unroll
        for (int c = 0; c < 8; ++c) { const u32x4 w = ((const u32x4*)base)[c];
            v[8 * c + 0] = bf_lo(w.x); v[8 * c + 1] = bf_hi(w.x); v[8 * c + 2] = bf_lo(w.y); v[8 * c + 3] = bf_hi(w.y); v[8 * c + 4] = bf_lo(w.z); v[8 * c + 5] = bf_hi(w.z); v[8 * c + 6] = bf_lo(w.w); v[8 * c + 7] = bf_hi(w.w); }
        if (isk) {
#pragma unroll
            for (int c = 0; c < 8; ++c) { const f32x4 w = ((const f32x4*)(KR + (size_t)t * 32))[c]; v[64 + 4 * c] = w.x; v[65 + 4 * c] = w.y; v[66 + 4 * c] = w.z; v[67 + 4 * c] = w.w; }
        } else {
#pragma unroll
            for (int c = 8; c < 12; ++c) { const u32x4 w = ((const u32x4*)base)[c];
                v[8 * c + 0] = bf_lo(w.x); v[8 * c + 1] = bf_hi(w.x); v[8 * c + 2] = bf_lo(w.y); v[8 * c + 3] = bf_hi(w.y); v[8 * c + 4] = bf_lo(w.z); v[8 * c + 5] = bf_hi(w.z); v[8 * c + 6] = bf_lo(w.w); v[8 * c + 7] = bf_hi(w.w); }
        }
        float ss = 0.f;
#pragma unroll
        for (int d = 0; d < 96; ++d) ss += v[d] * v[d];
        const float r = 1.0f / sqrtf(ss * (1.f / 96.f) + NORM_EPS);
        const float* g = isk ? gk : gq;
#pragma unroll
        for (int d = 0; d < 96; ++d) v[d] = (v[d] * r) * g[d];
        const float posf = (float)positions[t];
#pragma unroll
        for (int i = 0; i < 16; ++i) {
            const float ang = posf * c_invf[i];
            const double rev = (double)ang * 0.15915494309189535;
            const float fr = (float)(rev - rint(rev));
            const float cs = __builtin_amdgcn_cosf(fr), sn = __builtin_amdgcn_sinf(fr);
            const float x1 = v[64 + i], x2 = v[80 + i];
            v[64 + i] = x1 * cs - x2 * sn; v[80 + i] = x2 * cs + x1 * sn;
        }
        const float sc = isk ? 1.0f : QSCALE_MLA;
#pragma unroll
        for (int c = 0; c < 12; ++c) { u32x4 w; w.x = pk2(v[8 * c] * sc, v[8 * c + 1] * sc); w.y = pk2(v[8 * c + 2] * sc, v[8 * c + 3] * sc); w.z = pk2(v[8 * c + 4] * sc, v[8 * c + 5] * sc); w.w = pk2(v[8 * c + 6] * sc, v[8 * c + 7] * sc);
            ((u32x4*)base)[c] = w; }
    }
}

enum { M_SWIGLU = 0, M_RESID, M_INPROJ, M_QUP, M_KNOPE, M_VT, M_DUAL, M_SIGM, M_FINAL, M_RESID_FP, M_RESID_PP };
DI float sq8(const f32x4& a, const f32x4& b) { return (a[0] * a[0] + a[1] * a[1]) + (a[2] * a[2] + a[3] * a[3]) + (b[0] * b[0] + b[1] * b[1]) + (b[2] * b[2] + b[3] * b[3]); }
DI float quad_sum(float v) { v += __shfl_xor(v, 16); v += __shfl_xor(v, 32); return v; }
template <int MODE> struct Epi {
    static constexpr bool PERM = true, AFTER_DRAIN = false;
    void* o0; void* o1; void* o2; void* o3; void* o4; void* o5; const void* i0; const void* i1; float alpha;
    const float* rs; float rsn; float* rso; float* rso2; bf16* hb;
    const int* pos; const float* g2; const float* rs2;
    __device__ __forceinline__ bool zero_after(const pg8::Unit& u) const { if constexpr (MODE == M_DUAL) return u.half != 0; else return true; }
    __device__ __forceinline__ void operator()(pg8::f32x4 (&acc)[2][2][4][2], const pg8::Unit& u, int wr, int wc, int fr, int fq) const {
        const int rowb = u.pm * 256 + wr * 64 + fr;
        const int colb = u.pn * 256 + wc * 32 + 8 * fq;
        if constexpr (MODE == M_SWIGLU || MODE == M_INPROJ || MODE == M_QUP || MODE == M_SIGM) {
            float rsc[2][4];
#pragma unroll
            for (int ai = 0; ai < 2; ++ai)
#pragma unroll
                for (int m = 0; m < 4; ++m) rsc[ai][m] = rs[rowb + ai * 128 + m * 16];
#pragma unroll
            for (int ai = 0; ai < 2; ++ai)
#pragma unroll
                for (int m = 0; m < 4; ++m) rsc[ai][m] = __builtin_amdgcn_rsqf(rsc[ai][m] * rsn + NORM_EPS);
            if constexpr (MODE == M_SWIGLU) {
                const int col = u.pn * 128 + wc * 32 + 8 * fq;
#pragma unroll
                for (int ai = 0; ai < 2; ++ai)
#pragma unroll
                    for (int m = 0; m < 4; ++m) {
                        const float r = rsc[ai][m];
                        f32x4 a0 = acc[ai][0][m][0], a1 = acc[ai][0][m][1]; const f32x4 b0 = acc[ai][1][m][0], b1 = acc[ai][1][m][1];
#pragma unroll
                        for (int i = 0; i < 4; ++i) { const float x0 = a0[i] * r, x1 = a1[i] * r; a0[i] = x0 * sigmoidf_(x0) * (b0[i] * r); a1[i] = x1 * sigmoidf_(x1) * (b1[i] * r); }
                        *(u32x4*)((bf16*)o0 + (size_t)(rowb + ai * 128 + m * 16) * FF + col) = pack8(a0, a1);
                    }
            } else if constexpr (MODE == M_QUP) {
#pragma unroll
                for (int ai = 0; ai < 2; ++ai)
#pragma unroll
                    for (int m = 0; m < 4; ++m)
#pragma unroll
                        for (int bj = 0; bj < 2; ++bj)
                            *(u32x4*)((bf16*)o0 + (size_t)(rowb + ai * 128 + m * 16) * 768 + colb + bj * 128) = pack8(acc[ai][bj][m][0] * rsc[ai][m], acc[ai][bj][m][1] * rsc[ai][m]);
            } else if constexpr (MODE == M_SIGM) {
#pragma unroll
                for (int ai = 0; ai < 2; ++ai)
#pragma unroll
                    for (int m = 0; m < 4; ++m)
#pragma unroll
                        for (int bj = 0; bj < 2; ++bj) {
                            f32x4 v0 = acc[ai][bj][m][0] * rsc[ai][m], v1 = acc[ai][bj][m][1] * rsc[ai][m];
#pragma unroll
                            for (int i = 0; i < 4; ++i) { v0[i] = sigmoidf_(v0[i]); v1[i] = sigmoidf_(v1[i]); }
                            *(u32x4*)((bf16*)o0 + (size_t)(rowb + ai * 128 + m * 16) * DM + colb + bj * 128) = pack8(v0, v1);
                        }
            } else if (u.pn >= 7) {
                const int gcol = (u.pn - 7) * 128 + wc * 32 + 8 * fq;
#pragma unroll
                for (int ai = 0; ai < 2; ++ai)
#pragma unroll
                    for (int m = 0; m < 4; ++m) {
                        const int row = rowb + ai * 128 + m * 16; const float r = rsc[ai][m];
                        f32x4 a0 = acc[ai][0][m][0] * r, a1 = acc[ai][0][m][1] * r, b0 = acc[ai][1][m][0] * r, b1 = acc[ai][1][m][1] * r;
#pragma unroll
                        for (int i = 0; i < 4; ++i) { b0[i] = fmaxf(sigmoidf_(b0[i]), 1e-18f); b1[i] = fmaxf(sigmoidf_(b1[i]), 1e-18f);
                            a0[i] = sigmoidf_(a0[i]) * __builtin_amdgcn_rcpf(b0[i]); a1[i] = sigmoidf_(a1[i]) * __builtin_amdgcn_rcpf(b1[i]); }
                        bf16* gp = (bf16*)o5 + (size_t)row * 2048 + gcol;
                        *(u32x4*)gp = pack8(a0, a1); *(u32x4*)(gp + 1024) = pack8(b0, b1);
                    }
            } else {
#pragma unroll
                for (int ai = 0; ai < 2; ++ai)
#pragma unroll
                    for (int m = 0; m < 4; ++m) {
                        const int row = rowb + ai * 128 + m * 16; const float r = rsc[ai][m];
                        float ssq = 0.f, ssq2 = 0.f;
#pragma unroll
                        for (int bj = 0; bj < 2; ++bj) {
                            const int col0 = colb + bj * 128;
                            f32x4 v0 = acc[ai][bj][m][0] * r, v1 = acc[ai][bj][m][1] * r;
                            if (col0 < 384) { *(u32x4*)((bf16*)o0 + (size_t)row * 384 + col0) = pack8(v0, v1); ssq += sq8(v0, v1); }
                            else if (col0 < 640) { *(u32x4*)((bf16*)o1 + (size_t)row * 256 + (col0 - 384)) = pack8(v0, v1); ssq2 += sq8(v0, v1); }
                            else if (col0 < 672) {
                                const float sk = quad_sum(sq8(v0, v1));
                                if (fq == 0) rso[2 * T + row] = sk;
                                const int c0 = col0 - 640;
                                const f32x4 ga = *(const f32x4*)(g2 + 64 + c0), gb = *(const f32x4*)(g2 + 64 + c0 + 4);
                                v0 = v0 * ga; v1 = v1 * gb;
                                const float posf = (float)pos[row];
                                float xv[8] = {v0[0], v0[1], v0[2], v0[3], v1[0], v1[1], v1[2], v1[3]};
                                const int ib = (fq & 1) * 8; const bool second = fq >= 2;
#pragma unroll
                                for (int j = 0; j < 8; ++j) {
                                    const float other = __shfl_xor(xv[j], 32);
                                    const float ang = posf * c_invf[ib + j];
                                    const double rev = (double)ang * 0.15915494309189535;
                                    const float frc = (float)(rev - rint(rev));
                                    const float cs = __builtin_amdgcn_cosf(frc), sn = __builtin_amdgcn_sinf(frc);
                                    xv[j] = second ? (xv[j] * cs + other * sn) : (xv[j] * cs - other * sn);
                                }
                                float* kr = (float*)o2 + (size_t)row * 32 + c0;
                                *(f32x4*)kr = (f32x4){xv[0], xv[1], xv[2], xv[3]}; *(f32x4*)(kr + 4) = (f32x4){xv[4], xv[5], xv[6], xv[7]};
                            }
                            else if (col0 < 768) { }
                            else if (col0 < 1280) { *(u32x4*)((bf16*)o3 + (size_t)row * 512 + (col0 - 768)) = pack8(v0 * QSCALE_SB, v1 * QSCALE_SB); }
                            else if (col0 < 1792) { *(u32x4*)((bf16*)o4 + (size_t)row * 512 + (col0 - 1280)) = pack8(v0, v1); }
                            else { }
                        }
                        if (u.pn < 3) {
                            ssq = quad_sum(ssq); ssq2 = quad_sum(ssq2);
                            if (fq == 0) { if (u.pn < 2) unsafeAtomicAdd(rso + row, ssq); if (u.pn > 0) unsafeAtomicAdd(rso + T + row, ssq2); }
                        }
                    }
            }
        } else if constexpr (MODE == M_RESID || MODE == M_RESID_FP || MODE == M_RESID_PP) {
            constexpr int MB = (MODE == M_RESID_FP) ? 4 : 2;
#pragma unroll
            for (int ai = 0; ai < 2; ++ai)
#pragma unroll
            for (int mb = 0; mb < 4; mb += MB) {
                f32x4 pre[MB][2][2];
                if constexpr (MODE == M_RESID_FP) {
#pragma unroll
                    for (int m = 0; m < MB; ++m)
#pragma unroll
                        for (int bj = 0; bj < 2; ++bj) { const float* bp = (const float*)i0 + (size_t)(rowb + ai * 128 + (mb + m) * 16) * DM + colb + bj * 128; pre[m][bj][0] = *(const f32x4*)bp; pre[m][bj][1] = *(const f32x4*)(bp + 4); }
                } else {
                    u32x4 ph[MB][2], pl[MB][2];
#pragma unroll
                    for (int m = 0; m < MB; ++m)
#pragma unroll
                        for (int bj = 0; bj < 2; ++bj) { const size_t off = (size_t)(rowb + ai * 128 + (mb + m) * 16) * DM + colb + bj * 128; ph[m][bj] = *(const u32x4*)((const bf16*)i0 + off); pl[m][bj] = *(const u32x4*)((const bf16*)i1 + off); }
#pragma unroll
                    for (int m = 0; m < MB; ++m)
#pragma unroll
                        for (int bj = 0; bj < 2; ++bj) { const u32x4 a = ph[m][bj], b = pl[m][bj];
                            pre[m][bj][0] = (f32x4){bf_lo(a.x) + bf_lo(b.x), bf_hi(a.x) + bf_hi(b.x), bf_lo(a.y) + bf_lo(b.y), bf_hi(a.y) + bf_hi(b.y)};
                            pre[m][bj][1] = (f32x4){bf_lo(a.z) + bf_lo(b.z), bf_hi(a.z) + bf_hi(b.z), bf_lo(a.w) + bf_lo(b.w), bf_hi(a.w) + bf_hi(b.w)}; }
                }
#pragma unroll
                for (int m = 0; m < MB; ++m) {
                    const int row = rowb + ai * 128 + (mb + m) * 16; float ssq = 0.f;
#pragma unroll
                    for (int bj = 0; bj < 2; ++bj) {
                        const size_t off = (size_t)row * DM + colb + bj * 128;
                        const f32x4 r0 = pre[m][bj][0] + acc[ai][bj][mb + m][0] * alpha, r1 = pre[m][bj][1] + acc[ai][bj][mb + m][1] * alpha;
                        const u32x4 hi = pack8(r0, r1);
                        if constexpr (MODE == M_RESID) { *(f32x4*)((float*)o0 + off) = r0; *(f32x4*)((float*)o0 + off + 4) = r1; *(u32x4*)(hb + off) = hi; }
                        else {
                            const f32x4 d0 = {r0[0] - bf_lo(hi.x), r0[1] - bf_hi(hi.x), r0[2] - bf_lo(hi.y), r0[3] - bf_hi(hi.y)}, d1 = {r1[0] - bf_lo(hi.z), r1[1] - bf_hi(hi.z), r1[2] - bf_lo(hi.w), r1[3] - bf_hi(hi.w)};
                            *(u32x4*)((bf16*)o0 + off) = hi; *(u32x4*)((bf16*)o1 + off) = pack8(d0, d1);
                        }
                        ssq += sq8(r0, r1);
                    }
                    ssq = quad_sum(ssq);
                    if (fq == 0) unsafeAtomicAdd(rso + row, ssq);
                }
            }
        } else if constexpr (MODE == M_KNOPE) {
            const int hd = u.pn * 4 + wc;
#pragma unroll
            for (int ai = 0; ai < 2; ++ai) {
                float rkv[4], rkr[4]; f32x4 krr[4][2];
#pragma unroll
                for (int m = 0; m < 4; ++m) { const int row = rowb + ai * 128 + m * 16; rkv[m] = rs[row]; rkr[m] = rs2[row]; const float* kp = (const float*)i0 + (size_t)row * 32 + 8 * fq; krr[m][0] = *(const f32x4*)kp; krr[m][1] = *(const f32x4*)(kp + 4); }
                const f32x4 g00 = *(const f32x4*)(g2 + 8 * fq), g01 = *(const f32x4*)(g2 + 8 * fq + 4), g10 = *(const f32x4*)(g2 + 32 + 8 * fq), g11 = *(const f32x4*)(g2 + 32 + 8 * fq + 4);
#pragma unroll
                for (int m = 0; m < 4; ++m) {
                    const int row = rowb + ai * 128 + m * 16;
                    const float r = __builtin_amdgcn_rsqf(rkv[m] * rsn + NORM_EPS);
                    f32x4 a0 = acc[ai][0][m][0] * r, a1 = acc[ai][0][m][1] * r, b0 = acc[ai][1][m][0] * r, b1 = acc[ai][1][m][1] * r;
                    const float ss = quad_sum(sq8(a0, a1) + sq8(b0, b1)) + rkr[m];
                    const float rk = __builtin_amdgcn_rsqf(ss * (1.f / 96.f) + NORM_EPS);
                    bf16* kp = (bf16*)o0 + (size_t)row * 768 + hd * 96 + 8 * fq;
                    *(u32x4*)kp = pack8((a0 * rk) * g00, (a1 * rk) * g01);
                    *(u32x4*)(kp + 32) = pack8((b0 * rk) * g10, (b1 * rk) * g11);
                    *(u32x4*)(kp + 64) = pack8(krr[m][0] * rk, krr[m][1] * rk);
                }
            }
        } else if constexpr (MODE == M_VT) {
            f32x4 sc[2][2];
#pragma unroll
            for (int bj = 0; bj < 2; ++bj) { sc[bj][0] = *(const f32x4*)(rs + colb + bj * 128); sc[bj][1] = *(const f32x4*)(rs + colb + bj * 128 + 4); }
#pragma unroll
            for (int bj = 0; bj < 2; ++bj)
#pragma unroll
                for (int i = 0; i < 4; ++i) { sc[bj][0][i] = __builtin_amdgcn_rsqf(sc[bj][0][i] * rsn + NORM_EPS); sc[bj][1][i] = __builtin_amdgcn_rsqf(sc[bj][1][i] * rsn + NORM_EPS); }
#pragma unroll
            for (int ai = 0; ai < 2; ++ai)
#pragma unroll
                for (int m = 0; m < 4; ++m)
#pragma unroll
                    for (int bj = 0; bj < 2; ++bj) { const int col0 = colb + bj * 128;
                        *(u32x4*)((bf16*)o0 + (size_t)(col0 >> 12) * (512 * 4096) + (size_t)(rowb + ai * 128 + m * 16) * 4096 + (col0 & 4095)) = pack8(acc[ai][bj][m][0] * sc[bj][0], acc[ai][bj][m][1] * sc[bj][1]); }
        } else if constexpr (MODE == M_DUAL) {
            const bf16* G = (const bf16*)i0;
            if (u.half == 0) {
                u32x4 ga[2][4][2];
#pragma unroll
                for (int ai = 0; ai < 2; ++ai)
#pragma unroll
                    for (int m = 0; m < 4; ++m)
#pragma unroll
                        for (int bj = 0; bj < 2; ++bj) ga[ai][m][bj] = *(const u32x4*)(G + (size_t)(rowb + ai * 128 + m * 16) * 2048 + colb + bj * 128);
#pragma unroll
                for (int ai = 0; ai < 2; ++ai)
#pragma unroll
                    for (int m = 0; m < 4; ++m)
#pragma unroll
                        for (int bj = 0; bj < 2; ++bj) {
                            const u32x4 a = ga[ai][m][bj];
                            acc[ai][bj][m][0][0] *= bf_lo(a.x); acc[ai][bj][m][0][1] *= bf_hi(a.x); acc[ai][bj][m][0][2] *= bf_lo(a.y); acc[ai][bj][m][0][3] *= bf_hi(a.y);
                            acc[ai][bj][m][1][0] *= bf_lo(a.z); acc[ai][bj][m][1][1] *= bf_hi(a.z); acc[ai][bj][m][1][2] *= bf_lo(a.w); acc[ai][bj][m][1][3] *= bf_hi(a.w);
                        }
            } else {
                u32x4 gb[2][4][2];
#pragma unroll
                for (int ai = 0; ai < 2; ++ai)
#pragma unroll
                    for (int m = 0; m < 4; ++m)
#pragma unroll
                        for (int bj = 0; bj < 2; ++bj) gb[ai][m][bj] = *(const u32x4*)(G + (size_t)(rowb + ai * 128 + m * 16) * 2048 + 1024 + colb + bj * 128);
#pragma unroll
                for (int ai = 0; ai < 2; ++ai)
#pragma unroll
                    for (int m = 0; m < 4; ++m)
#pragma unroll
                        for (int bj = 0; bj < 2; ++bj) {
                            const u32x4 b = gb[ai][m][bj]; f32x4 v0 = acc[ai][bj][m][0], v1 = acc[ai][bj][m][1];
                            v0[0] *= bf_lo(b.x); v0[1] *= bf_hi(b.x); v0[2] *= bf_lo(b.y); v0[3] *= bf_hi(b.y); v1[0] *= bf_lo(b.z); v1[1] *= bf_hi(b.z); v1[2] *= bf_lo(b.w); v1[3] *= bf_hi(b.w);
                            *(u32x4*)((bf16*)o0 + (size_t)(rowb + ai * 128 + m * 16) * DM + colb + bj * 128) = pack8(v0, v1);
                        }
            }
        } else if constexpr (MODE == M_FINAL) {
#pragma unroll
            for (int ai = 0; ai < 2; ++ai)
#pragma unroll
            for (int mh = 0; mh < 2; ++mh) {
                u32x4 ph[2][2], pl[2][2], gt[2][2];
#pragma unroll
                for (int m = 0; m < 2; ++m)
#pragma unroll
                    for (int bj = 0; bj < 2; ++bj) { const size_t off = (size_t)(rowb + ai * 128 + (mh * 2 + m) * 16) * DM + colb + bj * 128;
                        ph[m][bj] = *(const u32x4*)((const bf16*)i0 + off); pl[m][bj] = *(const u32x4*)((const bf16*)o1 + off); gt[m][bj] = *(const u32x4*)((const bf16*)i1 + off); }
#pragma unroll
                for (int m = 0; m < 2; ++m)
#pragma unroll
                    for (int bj = 0; bj < 2; ++bj) { const size_t off = (size_t)(rowb + ai * 128 + (mh * 2 + m) * 16) * DM + colb + bj * 128;
                        const u32x4 g = gt[m][bj], a = ph[m][bj], b = pl[m][bj]; const f32x4 v0 = acc[ai][bj][mh * 2 + m][0], v1 = acc[ai][bj][mh * 2 + m][1]; f32x4 r0, r1;
                        r0[0] = (bf_lo(a.x) + bf_lo(b.x)) + bf_lo(g.x) * v0[0]; r0[1] = (bf_hi(a.x) + bf_hi(b.x)) + bf_hi(g.x) * v0[1]; r0[2] = (bf_lo(a.y) + bf_lo(b.y)) + bf_lo(g.y) * v0[2]; r0[3] = (bf_hi(a.y) + bf_hi(b.y)) + bf_hi(g.y) * v0[3];
                        r1[0] = (bf_lo(a.z) + bf_lo(b.z)) + bf_lo(g.z) * v1[0]; r1[1] = (bf_hi(a.z) + bf_hi(b.z)) + bf_hi(g.z) * v1[1]; r1[2] = (bf_lo(a.w) + bf_lo(b.w)) + bf_lo(g.w) * v1[2]; r1[3] = (bf_hi(a.w) + bf_hi(b.w)) + bf_hi(g.w) * v1[3];
                        *(f32x4*)((float*)o0 + off) = r0; *(f32x4*)((float*)o0 + off + 4) = r1; }
            }
        }
    }
};
struct DualOrder {
    pg8::StaticOrder S;
    __device__ bool next(int i, pg8::Unit& u) const { const bool ok = S.next(i >> 1, u); u.half = i & 1; return ok; }
    __device__ __forceinline__ void a_ready(const pg8::Unit&) const {}
    __device__ __forceinline__ void done(const pg8::Unit&) const {}
};
template <int MODE> DI void run_gemm(LAS uchar* lds, const bf16* A, const bf16* Bt, int M, int N, int K, const Epi<MODE>& E, int wave_s) {
    asm volatile("" : "+s"(M), "+s"(N), "+s"(K));
    pg8::Gemm g{A, Bt, M, N, K, nullptr, nullptr}; pg8::StaticOrder S; S.init(M, N, (int)gridDim.x, (int)blockIdx.x);
    pg8::gemm_phase<Epi<MODE>, pg8::StaticOrder, PG8_ALIGN, PG8_SP2>(lds, g, S, E, wave_s);
}
DI void run_gemm_dual(LAS uchar* lds, const bf16* A, const bf16* Bt, const bf16* A2, const bf16* Bt2, int M, int N, int K, const Epi<M_DUAL>& E, int wave_s) {
    asm volatile("" : "+s"(M), "+s"(N), "+s"(K));
    pg8::Gemm g{A, Bt, M, N, K, A2, Bt2}; DualOrder S; S.S.init(M, N, (int)gridDim.x, (int)blockIdx.x);
    pg8::gemm_phase<Epi<M_DUAL>, DualOrder, PG8_ALIGN, PG8_SP2>(lds, g, S, E, wave_s);
}

DI int crow(int reg, int h) { return (reg & 3) + 8 * (reg >> 2) + 4 * h; }
constexpr int KP_MLA = 208, KP_SB = 144, VP = 144;
constexpr int LDS_K = 0, LDS_V = 16384, LDS_FLAGS = 32768;

constexpr int MLA_BUF = 24576, MLA_VOFF = 13312;
#define LBAR() do { asm volatile("s_waitcnt lgkmcnt(0)" ::: "memory"); __builtin_amdgcn_s_barrier(); asm volatile("" ::: "memory"); } while (0)
constexpr int MLA_SUB = 22528, MLA_BIG = 2 * MLA_SUB;
DI void mla_qk_t(LAS uchar* ldsK, int r, int h, const f32x16& negv, const bf16x8 (&qf)[6], f32x16& s0, f32x16& s1) {
    bf16x8 a0[6], a1[6];
#pragma unroll
    for (int kb = 0; kb < 6; ++kb) { a0[kb] = *(const LAS bf16x8*)(ldsK + r * KP_MLA + (16 * kb + 8 * h) * 2); a1[kb] = *(const LAS bf16x8*)(ldsK + (32 + r) * KP_MLA + (16 * kb + 8 * h) * 2); }
    s0 = MFMA32(a0[0], qf[0], negv); s1 = MFMA32(a1[0], qf[0], negv);
#pragma unroll
    for (int kb = 1; kb < 6; ++kb) { s0 = MFMA32(a0[kb], qf[kb], s0); s1 = MFMA32(a1[kb], qf[kb], s1); }
}
DI void mla_sm_t(f32x16& s0, f32x16& s1, bf16x8 (&P)[4], float& lrun) {
#pragma unroll
    for (int i = 0; i < 16; ++i) { s0[i] = __builtin_amdgcn_exp2f(s0[i]); s1[i] = __builtin_amdgcn_exp2f(s1[i]); }
    float pa[8];
#pragma unroll
    for (int i = 0; i < 8; ++i) pa[i] = (s0[i] + s0[8 + i]) + (s1[i] + s1[8 + i]);
    lrun += ((pa[0] + pa[1]) + (pa[2] + pa[3])) + ((pa[4] + pa[5]) + (pa[6] + pa[7]));
#pragma unroll
    for (int t = 0; t < 2; ++t) {
        u32x4 pa, pb;
        pa.x = pk2(s0[8 * t], s0[8 * t + 1]); pa.y = pk2(s0[8 * t + 2], s0[8 * t + 3]); pa.z = pk2(s0[8 * t + 4], s0[8 * t + 5]); pa.w = pk2(s0[8 * t + 6], s0[8 * t + 7]);
        pb.x = pk2(s1[8 * t], s1[8 * t + 1]); pb.y = pk2(s1[8 * t + 2], s1[8 * t + 3]); pb.z = pk2(s1[8 * t + 4], s1[8 * t + 5]); pb.w = pk2(s1[8 * t + 6], s1[8 * t + 7]);
        P[t] = __builtin_bit_cast(bf16x8, pa); P[2 + t] = __builtin_bit_cast(bf16x8, pb);
    }
}
DI void mla_pv_t(LAS uchar* ldsV, int r, int h, const bf16x8 (&P)[4], f32x16& o0, f32x16& o1) {
#pragma unroll
    for (int q = 0; q < 4; ++q) {
        const int koff = (16 * q + 4 * h) * 2;
        { const s16x4 lo = *(const LAS s16x4*)(ldsV + r * VP + koff), hi = *(const LAS s16x4*)(ldsV + r * VP + koff + 16);
          o0 = MFMA32(__builtin_shufflevector(lo, hi, 0, 1, 2, 3, 4, 5, 6, 7), P[q], o0); }
        { const s16x4 lo = *(const LAS s16x4*)(ldsV + (32 + r) * VP + koff), hi = *(const LAS s16x4*)(ldsV + (32 + r) * VP + koff + 16);
          o1 = MFMA32(__builtin_shufflevector(lo, hi, 0, 1, 2, 3, 4, 5, 6, 7), P[q], o1); }
    }
}
DI void mla_step2(LAS uchar* buf, int J, int jmax, int q0, int r, int h, const f32x16& negv, const bf16x8 (&qf)[6], f32x16& o0, f32x16& o1, float& lrun) {
    const int j0 = 2 * J;
    if (j0 + 1 < jmax) {
        f32x16 sa0, sa1, sb0, sb1; bf16x8 Pa[4], Pb[4];
        mla_qk_t(buf, r, h, negv, qf, sa0, sa1);
        mla_qk_t(buf + MLA_SUB, r, h, negv, qf, sb0, sb1);
        mla_sm_t(sa0, sa1, Pa, lrun);
        mla_pv_t(buf + MLA_VOFF, r, h, Pa, o0, o1);
        mla_sm_t(sb0, sb1, Pb, lrun);
        mla_pv_t(buf + MLA_SUB + MLA_VOFF, r, h, Pb, o0, o1);
        __builtin_amdgcn_sched_group_barrier(0x100, 12, 0); __builtin_amdgcn_sched_group_barrier(0x008, 12, 0);
        __builtin_amdgcn_sched_group_barrier(0x100, 12, 0);
#pragma unroll
        for (int g_ = 0; g_ < 12; ++g_) { __builtin_amdgcn_sched_group_barrier(0x008, 1, 0); __builtin_amdgcn_sched_group_barrier(0x002, 8, 0); }
    } else {
#pragma unroll
        for (int sub = 0; sub < 2; ++sub) {
            const int j = j0 + sub;
            if (j <= jmax) {
                f32x16 s0, s1; bf16x8 P[4];
                mla_qk_t(buf + sub * MLA_SUB, r, h, negv, qf, s0, s1);
                __builtin_amdgcn_sched_group_barrier(0x100, 12, 0); __builtin_amdgcn_sched_group_barrier(0x008, 12, 0);
                if (j == jmax) { const int tq = q0 + r - 64 * j;
#pragma unroll
                    for (int i = 0; i < 16; ++i) { if (crow(i, h) > tq) s0[i] = -INFINITY; if (32 + crow(i, h) > tq) s1[i] = -INFINITY; } }
                mla_sm_t(s0, s1, P, lrun);
                mla_pv_t(buf + sub * MLA_SUB + MLA_VOFF, r, h, P, o0, o1);
            }
        }
    }
}
DI void mla_unit(LAS uchar* lds, const bf16* Qm, const bf16* Km, const bf16* Vt, bf16* O, const int* positions, const float* gq, const float* gk, int bh, int qb, int tid, int wid, int lane) {
    asm volatile("" : "+v"(tid), "+v"(lane));
    asm volatile("" : "+s"(gq), "+s"(gk));
    const int b = bh >> 3, hd = bh & 7, r = lane & 31, h = lane >> 5;
    const size_t tbase = (size_t)b * SEQ;
    const int q0 = qb * 256 + wid * 32;
    const int nt = 4 * (qb + 1), jmax = 4 * qb + (wid >> 1);
    const int NT2 = nt >> 1;
    const char* kg = (const char*)(Km + tbase * 768 + hd * 96);
    const char* vg = (const char*)(Vt + (size_t)bh * 64 * SEQ);
    unsigned dvo[3], dts[3], dlo[3]; const char* dgb[3];
#pragma unroll
    for (int k = 0; k < 3; ++k) { const int q = wid + 8 * k;
        if (q < 13) { const int s = 64 * q + lane, row = s / 13, c = s % 13; dgb[k] = kg; dts[k] = 64u * 1536u; dvo[k] = (unsigned)(row * 1536 + (c < 12 ? c : 11) * 16); dlo[k] = 1024u * q; }
        else { const int i = q - 13, s = 64 * i + lane, row = s / 9, c = s % 9; dgb[k] = vg; dts[k] = 128u; dvo[k] = (unsigned)(row * (SEQ * 2) + (c < 8 ? c : 7) * 16); dlo[k] = MLA_VOFF + 1024u * i; } }
    const bool three = wid < 6;
#define MLA_ISSUE1(jt, off) do { _Pragma("unroll") for (int k_ = 0; k_ < 3; ++k_) if (k_ < 2 || three) \
        __builtin_amdgcn_global_load_lds((const unsigned*)(dgb[k_] + (size_t)(jt) * dts[k_] + dvo[k_]), (LAS unsigned*)(lds + (off) + dlo[k_]), 16, 0, 0); } while (0)
#define MLA_ISSUE2(JJ) do { const int bo_ = ((JJ) % 3) * MLA_BIG; MLA_ISSUE1(2 * (JJ), bo_); MLA_ISSUE1(2 * (JJ) + 1, bo_ + MLA_SUB); } while (0)
    MLA_ISSUE2(0); if (NT2 > 1) MLA_ISSUE2(1);
    __builtin_amdgcn_sched_barrier(0);
    bf16x8 qf[6]; float negm;
    { const bf16* qp = Qm + (tbase + q0 + r) * 768 + hd * 96 + 8 * h;
      float gmax = 0.f;
#pragma unroll
      for (int kb = 0; kb < 6; ++kb) { const f32x4 ka = *(const f32x4*)(gk + 16 * kb + 8 * h), kb4 = *(const f32x4*)(gk + 16 * kb + 8 * h + 4);
#pragma unroll
          for (int j = 0; j < 4; ++j) gmax = fmaxf(gmax, fmaxf(fabsf(ka[j]), fabsf(kb4[j]))); }
      gmax = fmaxf(gmax, __shfl_xor(gmax, 32));
      asm volatile("" : "+v"(gmax));
      float qv[6][8]; float ss = 0.f;
#pragma unroll
      for (int kb = 0; kb < 6; ++kb) { const u32x4 w = *(const u32x4*)(qp + 16 * kb);
          qv[kb][0] = bf_lo(w.x); qv[kb][1] = bf_hi(w.x); qv[kb][2] = bf_lo(w.y); qv[kb][3] = bf_hi(w.y); qv[kb][4] = bf_lo(w.z); qv[kb][5] = bf_hi(w.z); qv[kb][6] = bf_lo(w.w); qv[kb][7] = bf_hi(w.w); }
#pragma unroll
      for (int kb = 0; kb < 6; ++kb)
#pragma unroll
          for (int j = 0; j < 8; ++j) ss += qv[kb][j] * qv[kb][j];
      ss += __shfl_xor(ss, 32);
      const float rq = __builtin_amdgcn_rsqf(ss * (1.f / 96.f) + NORM_EPS);
      float qn2 = 0.f;
#pragma unroll
      for (int kb = 0; kb < 6; ++kb) { const f32x4 ga = *(const f32x4*)(gq + 16 * kb + 8 * h), gb = *(const f32x4*)(gq + 16 * kb + 8 * h + 4);
#pragma unroll
          for (int j = 0; j < 4; ++j) { qv[kb][j] = (qv[kb][j] * rq) * ga[j]; qv[kb][4 + j] = (qv[kb][4 + j] * rq) * gb[j];
              qn2 += qv[kb][j] * qv[kb][j] + qv[kb][4 + j] * qv[kb][4 + j]; } }
      qn2 += __shfl_xor(qn2, 32);
      negm = -(1.02f * QSCALE_MLA * 9.79795897f) * sqrtf(qn2) * gmax;
      const float posf = (float)positions[tbase + q0 + r];
#pragma unroll
      for (int j = 0; j < 8; ++j) {
          const float ang = posf * c_invf[8 * h + j];
          const double rev = (double)ang * 0.15915494309189535;
          const float frc = (float)(rev - rint(rev));
          const float cs = __builtin_amdgcn_cosf(frc), sn = __builtin_amdgcn_sinf(frc);
          const float x1 = qv[4][j], x2 = qv[5][j];
          qv[4][j] = x1 * cs - x2 * sn; qv[5][j] = x2 * cs + x1 * sn;
      }
#pragma unroll
      for (int kb = 0; kb < 6; ++kb) { u32x4 w; w.x = pk2(qv[kb][0] * QSCALE_MLA, qv[kb][1] * QSCALE_MLA); w.y = pk2(qv[kb][2] * QSCALE_MLA, qv[kb][3] * QSCALE_MLA); w.z = pk2(qv[kb][4] * QSCALE_MLA, qv[kb][5] * QSCALE_MLA); w.w = pk2(qv[kb][6] * QSCALE_MLA, qv[kb][7] * QSCALE_MLA);
          qf[kb] = __builtin_bit_cast(bf16x8, w); } }
    f32x16 o0, o1;
#pragma unroll
    for (int i = 0; i < 16; ++i) { o0[i] = 0.f; o1[i] = 0.f; }
    float lrun = 0.f;
    f32x16 negv;
#pragma unroll
    for (int i = 0; i < 16; ++i) negv[i] = negm;
    asm volatile("" : "+v"(negv));
    if (NT2 > 1) { if (three) asm volatile("s_waitcnt vmcnt(6)" ::: "memory"); else asm volatile("s_waitcnt vmcnt(4)" ::: "memory"); } else asm volatile("s_waitcnt vmcnt(0)" ::: "memory");
    LBAR();
    for (int J = 0; J < NT2; ++J) {
        if (J + 2 < NT2) MLA_ISSUE2(J + 2);
        if (2 * J <= jmax) mla_step2(lds + (J % 3) * MLA_BIG, J, jmax, q0, r, h, negv, qf, o0, o1, lrun);
        if (J + 2 < NT2) { if (three) asm volatile("s_waitcnt vmcnt(6)" ::: "memory"); else asm volatile("s_waitcnt vmcnt(4)" ::: "memory"); }
        else asm volatile("s_waitcnt vmcnt(0)" ::: "memory");
        LBAR();
    }
#undef MLA_ISSUE1
#undef MLA_ISSUE2
#define MLA_STEP 0
#undef MLA_STEP
#undef MLA_LOAD
#undef MLA_STORE
    lrun += __shfl_xor(lrun, 32);
    const float inv = 1.0f / lrun;
    bf16* op = O + (tbase + q0 + r) * 512 + hd * 64 + 4 * h;
#pragma unroll
    for (int g = 0; g < 4; ++g) {
        u32x2 w0, w1; w0.x = pk2(o0[4 * g] * inv, o0[4 * g + 1] * inv); w0.y = pk2(o0[4 * g + 2] * inv, o0[4 * g + 3] * inv);
        w1.x = pk2(o1[4 * g] * inv, o1[4 * g + 1] * inv); w1.y = pk2(o1[4 * g + 2] * inv, o1[4 * g + 3] * inv);
        *(u32x2*)(op + 8 * g) = w0; *(u32x2*)(op + 32 + 8 * g) = w1;
    }
}

DI void sb_subtile(f32x16& z, bool diag, int tq, int koffs, int h, float& carry) {
    float R[16];
#pragma unroll
    for (int i = 0; i < 16; ++i) { const bool msk = diag && (koffs + crow(i, h) >= tq); const float E = __builtin_amdgcn_exp2f(fminf(z[i], 100.f)); const float rr = __builtin_amdgcn_rcpf(1.0f + E);
        R[i] = msk ? 1.0f : rr; z[i] = msk ? 0.f : E * rr; }
    float G[4], PG[4];
#pragma unroll
    for (int g = 0; g < 4; ++g) { G[g] = (R[4 * g] * R[4 * g + 1]) * (R[4 * g + 2] * R[4 * g + 3]); PG[g] = __shfl_xor(G[g], 32); }
    float Rr = carry;
#pragma unroll
    for (int g = 3; g >= 0; --g) {
        const float e3 = (h == 0) ? Rr * PG[g] : Rr, e2 = e3 * R[4 * g + 3], e1 = e2 * R[4 * g + 2], e0 = e1 * R[4 * g + 1];
        z[4 * g + 3] *= e3; z[4 * g + 2] *= e2; z[4 * g + 1] *= e1; z[4 * g + 0] *= e0;
        Rr *= G[g] * PG[g];
    }
    carry = Rr;
}
DI bool sb_compute(LAS uchar* ldsK, LAS uchar* ldsV, int j, int jmax, int q0, int r, int h, const bf16x8 (&qf)[4], f32x16& o0, f32x16& o1, float& carry) {
    f32x16 s0, s1;
#pragma unroll
    for (int q = 0; q < 16; ++q) { s0[q] = 0.f; s1[q] = 0.f; }
    { bf16x8 a0[4], a1[4];
#pragma unroll
      for (int kb = 0; kb < 4; ++kb) { a0[kb] = *(const LAS bf16x8*)(ldsK + r * KP_SB + (16 * kb + 8 * h) * 2); a1[kb] = *(const LAS bf16x8*)(ldsK + (32 + r) * KP_SB + (16 * kb + 8 * h) * 2); }
#pragma unroll
      for (int kb = 0; kb < 4; ++kb) { s0 = MFMA32(a0[kb], qf[kb], s0); s1 = MFMA32(a1[kb], qf[kb], s1); }
      __builtin_amdgcn_sched_group_barrier(0x100, 8, 0);
      __builtin_amdgcn_sched_group_barrier(0x008, 8, 0); }
    const int tq = q0 + r - 64 * j; const bool diag = (j == jmax);
    sb_subtile(s1, diag, tq, 32, h, carry);
    sb_subtile(s0, diag, tq, 0, h, carry);
#pragma unroll
    for (int sub = 0; sub < 2; ++sub)
#pragma unroll
        for (int s = 0; s < 2; ++s) {
            u32x4 pw;
            if (sub == 0) { pw.x = pk2(s0[8 * s], s0[8 * s + 1]); pw.y = pk2(s0[8 * s + 2], s0[8 * s + 3]); pw.z = pk2(s0[8 * s + 4], s0[8 * s + 5]); pw.w = pk2(s0[8 * s + 6], s0[8 * s + 7]); }
            else          { pw.x = pk2(s1[8 * s], s1[8 * s + 1]); pw.y = pk2(s1[8 * s + 2], s1[8 * s + 3]); pw.z = pk2(s1[8 * s + 4], s1[8 * s + 5]); pw.w = pk2(s1[8 * s + 6], s1[8 * s + 7]); }
            const bf16x8 pb = __builtin_bit_cast(bf16x8, pw);
            const int koff = (32 * sub + 16 * s + 4 * h) * 2;
            { const s16x4 lo = *(const LAS s16x4*)(ldsV + r * VP + koff), hi = *(const LAS s16x4*)(ldsV + r * VP + koff + 16);
              o0 = MFMA32(__builtin_shufflevector(lo, hi, 0, 1, 2, 3, 4, 5, 6, 7), pb, o0); }
            { const s16x4 lo = *(const LAS s16x4*)(ldsV + (32 + r) * VP + koff), hi = *(const LAS s16x4*)(ldsV + (32 + r) * VP + koff + 16);
              o1 = MFMA32(__builtin_shufflevector(lo, hi, 0, 1, 2, 3, 4, 5, 6, 7), pb, o1); }
        }
    return __builtin_amdgcn_ballot_w64(carry == 0.f) == ~0ull;
}
#ifndef SB_WIN_BACK
#define SB_WIN_BACK 3
#endif
constexpr int SBW = 18432, SB_FLAGS = 132096;
DI void sb_unit(LAS uchar* lds, const bf16* Qs, const bf16* Ks, const bf16* Vt, bf16* O, int bh, int qb, int tid, int wid, int lane) {
    asm volatile("" : "+v"(tid), "+v"(lane));
    const int b = bh >> 3, hd = bh & 7, r = lane & 31, h = lane >> 5;
    const size_t tbase = (size_t)b * SEQ;
    const int q0 = qb * 256 + wid * 32;
    const int jmax = 4 * qb + (wid >> 1), jlo = (4 * qb - SB_WIN_BACK > 0) ? 4 * qb - SB_WIN_BACK : 0, ntw = 4 * qb + 4 - jlo;
    { const char* kgb = (const char*)(Ks + tbase * 512 + hd * 64); const char* vgb = (const char*)(Vt + (size_t)bh * 64 * SEQ);
      for (int p = wid; p < 18 * ntw; p += 8) {
          const int tw = p / 18, q = p - 18 * tw, qi = q < 9 ? q : q - 9, s = 64 * qi + lane, row = s / 9, c0 = s - 9 * row, c = c0 < 8 ? c0 : 7, j = jlo + tw;
          const char* g = (q < 9) ? kgb + (size_t)(64 * j + row) * 1024 + c * 16 : vgb + ((size_t)row * SEQ + 64 * j) * 2 + c * 16;
          __builtin_amdgcn_global_load_lds((const unsigned*)g, (LAS unsigned*)(lds + tw * SBW + (q < 9 ? 0 : 9216) + 1024 * qi), 16, 0, 0);
      } }
    bf16x8 qf[4];
    { const bf16* qp = Qs + (tbase + q0 + r) * 512 + hd * 64 + 8 * h;
#pragma unroll
      for (int kb = 0; kb < 4; ++kb) qf[kb] = *(const bf16x8*)(qp + 16 * kb); }
    f32x16 o0, o1;
#pragma unroll
    for (int q = 0; q < 16; ++q) { o0[q] = 0.f; o1[q] = 0.f; }
    float carry = 1.0f;
    volatile LAS unsigned* flags = (volatile LAS unsigned*)(lds + SB_FLAGS);
    asm volatile("s_waitcnt vmcnt(0)" ::: "memory");
    LBAR();
    bool done = false;
    for (int j = jmax; j >= jlo && !done; --j) { LAS uchar* sl = lds + (j - jlo) * SBW; done = sb_compute(sl, sl + 9216, j, jmax, q0, r, h, qf, o0, o1, carry); }
    if (lane == 0) flags[16 + wid] = (!done && jlo > 0) ? 1u : 0u;
    LBAR();
    unsigned more = 0u;
#pragma unroll
    for (int w = 0; w < 8; ++w) more |= flags[16 + w];
    if (more) {
        const int ntg = jlo;
        const bf16* kg = Ks + (tbase + (tid >> 3)) * 512 + hd * 64 + (tid & 7) * 8;
        const bf16* vg = Vt + ((size_t)bh * 64 + (tid >> 3)) * SEQ + (tid & 7) * 8;
        struct KV2 { u32x4 ka, va; };
        KV2 R0, R1, R2;
        bool stop = false;
#define SB_LOAD(R, ii) do { const int jt_ = ntg - 1 - (ii); R.ka = *(const u32x4*)(kg + (size_t)(64 * jt_) * 512); R.va = *(const u32x4*)(vg + 64 * jt_); } while (0)
#define SB_STORE(R, bb) do { LAS uchar* kb_ = lds + (bb) * MLA_BUF; *(LAS u32x4*)(kb_ + (tid >> 3) * KP_SB + (tid & 7) * 16) = R.ka; *(LAS u32x4*)(kb_ + MLA_VOFF + (tid >> 3) * VP + (tid & 7) * 16) = R.va; } while (0)
#define SB_STEP(ii, R) do { const int i_ = (ii), j_ = ntg - 1 - i_; if (i_ + 1 < ntg) SB_STORE(R, (i_ + 1) & 1); if (i_ + 4 < ntg) SB_LOAD(R, i_ + 4); \
        if (!done && j_ <= jmax) { LAS uchar* kb2_ = lds + (i_ & 1) * MLA_BUF; done = sb_compute(kb2_, kb2_ + MLA_VOFF, j_, jmax, q0, r, h, qf, o0, o1, carry); } \
        if (lane == 0) flags[(i_ & 1) * 8 + wid] = done ? 1u : 0u; \
        LBAR(); \
        { unsigned all_ = 1u; _Pragma("unroll") for (int w_ = 0; w_ < 8; ++w_) all_ &= flags[(i_ & 1) * 8 + w_]; stop = all_ != 0u; } } while (0)
        SB_LOAD(R0, 0); if (ntg > 1) SB_LOAD(R1, 1); if (ntg > 2) SB_LOAD(R2, 2);
        SB_STORE(R0, 0); if (ntg > 3) SB_LOAD(R0, 3);
        LBAR();
        for (int i3 = 0; i3 < ntg; i3 += 3) {
            SB_STEP(i3, R1); if (stop || i3 + 1 >= ntg) break;
            SB_STEP(i3 + 1, R2); if (stop || i3 + 2 >= ntg) break;
            SB_STEP(i3 + 2, R0); if (stop) break;
        }
#undef SB_LOAD
#undef SB_STORE
#undef SB_STEP
    }
    LBAR();
    bf16* op = O + (tbase + q0 + r) * 512 + hd * 64 + 4 * h;
#pragma unroll
    for (int g = 0; g < 4; ++g) {
        u32x2 w0, w1; w0.x = pk2(o0[4 * g], o0[4 * g + 1]); w0.y = pk2(o0[4 * g + 2], o0[4 * g + 3]);
        w1.x = pk2(o1[4 * g], o1[4 * g + 1]); w1.y = pk2(o1[4 * g + 2], o1[4 * g + 3]);
        *(u32x2*)(op + 8 * g) = w0; *(u32x2*)(op + 32 + 8 * g) = w1;
    }
}

#define XB_TMO      128
#define XB_XCNT(j)  (256  + 64 * (j))
#define XB_XSUB(j)  (1280 + 64 * (j))
#define XB_XGEN(j)  (2304 + 64 * (j))
#define XB_TOP      3328
#define XB_TOPGEN   3392
#define XCD_BAR_WORDS 3456
#define XB_SPIN_CAP (1u << 18)

__device__ __forceinline__ unsigned xb_ld(unsigned* p)              { return __hip_atomic_load(p, __ATOMIC_RELAXED, __HIP_MEMORY_SCOPE_AGENT); }
__device__ __forceinline__ unsigned xb_add(unsigned* p, unsigned v) { return __hip_atomic_fetch_add(p, v, __ATOMIC_RELAXED, __HIP_MEMORY_SCOPE_AGENT); }
__device__ __forceinline__ unsigned xb_xcc_id() { return (unsigned)__builtin_amdgcn_s_getreg((3 << 11) | 20) & 0xFu; }
#define XB_SPIN(cond, bar) do { unsigned _sp = 0; while (cond) { __builtin_amdgcn_s_sleep(1); \
    if ((++_sp & 255u) == 0u) { if (xb_ld(&(bar)[XB_TMO])) break; if (_sp > XB_SPIN_CAP) { atomicAdd(&(bar)[XB_TMO], 1u); break; } } } } while (0)

struct XcdBarrier {
    unsigned* bar; unsigned x;
    volatile LAS unsigned* st;
};

__device__ __forceinline__ XcdBarrier xcd_barrier_post(unsigned* bar, volatile LAS unsigned* st, const bool is_t0) {
    XcdBarrier b; b.bar = bar; b.x = xb_xcc_id(); b.st = st;
    if (is_t0) (void)xb_add(&bar[XB_XCNT(b.x)], 1u);
    return b;
}
__device__ __forceinline__ void xcd_barrier_complete(unsigned* bar, unsigned x, unsigned& nloc, unsigned& nx) {
    const unsigned G = gridDim.x * gridDim.y * gridDim.z;
    unsigned sum, cnt, mine, sp = 0u;
    for (;;) {
        sum = 0u; cnt = 0u; mine = 0u;
#pragma unroll
        for (unsigned j = 0; j < 16; ++j) { const unsigned c = xb_ld(&bar[XB_XCNT(j)]); sum += c; cnt += (c > 0u) ? 1u : 0u; mine = (j == x) ? c : mine; }
        if (sum == G) break;
        __builtin_amdgcn_s_sleep(1);
        if ((++sp & 255u) == 0u) { if (xb_ld(&bar[XB_TMO])) break; if (sp > XB_SPIN_CAP) { atomicAdd(&bar[XB_TMO], 1u); break; } }
    }
    nloc = mine > 0u ? mine : 1u; nx = cnt > 0u ? cnt : 1u;
}

__device__ __forceinline__ void xcd_barrier(const XcdBarrier& b, const int wave_s) {
    unsigned z_ = 0u; asm volatile("" : "+v"(z_));
    const bool is_t0 = (wave_s == 0) && (__builtin_amdgcn_mbcnt_hi(~0u, __builtin_amdgcn_mbcnt_lo(~0u, z_)) == 0u);
    asm volatile("s_waitcnt vmcnt(0)" ::: "memory");
    __syncthreads();
    if (is_t0) {
        unsigned* bar = b.bar;
        __builtin_amdgcn_s_waitcnt(0);
        unsigned nloc = b.st[0], nx = b.st[1];
        if (nloc == 0u) { xcd_barrier_complete(bar, b.x, nloc, nx); b.st[0] = nloc; b.st[1] = nx; }
        const unsigned old = xb_add(&bar[XB_XSUB(b.x)], 1u);
        const unsigned gen = old / nloc;
        if (old + 1u == (gen + 1u) * nloc) {
            __builtin_amdgcn_fence(__ATOMIC_RELEASE, "agent");
            asm volatile("s_waitcnt vmcnt(0)" ::: "memory");
            const unsigned og = xb_add(&bar[XB_TOP], 1u);
            const unsigned tg = og / nx;
            if (og + 1u == (tg + 1u) * nx) xb_add(&bar[XB_TOPGEN], 1u);
            else XB_SPIN(xb_ld(&bar[XB_TOPGEN]) == tg, bar);
            __builtin_amdgcn_fence(__ATOMIC_ACQUIRE, "agent");
            xb_add(&bar[XB_XGEN(b.x)], 1u);
            asm volatile("s_waitcnt vmcnt(0)" ::: "memory");
        } else {
            XB_SPIN(xb_ld(&bar[XB_XGEN(b.x)]) == gen, bar);
            __builtin_amdgcn_fence(__ATOMIC_ACQUIRE, "agent");
            asm volatile("s_waitcnt vmcnt(0)" ::: "memory");
        }
    }
    __syncthreads();
}

__global__ void __launch_bounds__(512, 2) mega_fwd(Params P) {
    extern __shared__ __attribute__((aligned(16))) unsigned char lds_raw[];
    LAS uchar* lds = (LAS uchar*)lds_raw;
    cg::grid_group grid = cg::this_grid();
    const int wave_s = __builtin_amdgcn_readfirstlane(threadIdx.x >> 6);
    const int G = gridDim.x, NGW = G * 8, NT = G * 512;
#define FRESH() unsigned z_ = 0u; asm volatile("" : "+v"(z_)); const int tid = wave_s * 64 + (int)__builtin_amdgcn_mbcnt_hi(~0u, __builtin_amdgcn_mbcnt_lo(~0u, z_)); const int lane = tid & 63, wave = wave_s, gw = blockIdx.x * 8 + wave, gtid = blockIdx.x * 512 + tid; (void)lane; (void)gw; (void)gtid;
    unsigned char* ws = P.ws;
    const float* x = P.in[0];
    bf16* XN = (bf16*)(ws + WS_XN); float* H = (float*)(ws + WS_H); bf16* ACT = (bf16*)(ws + WS_ACT);
    bf16* CQ = (bf16*)(ws + WS_CQ); bf16* CKV = (bf16*)(ws + WS_CKV); float* KR = (float*)(ws + WS_KR);
    bf16* SBQ = (bf16*)(ws + WS_SBQ); bf16* SBK = (bf16*)(ws + WS_SBK); bf16* VTS = (bf16*)(ws + WS_VTS);
    bf16* QM = (bf16*)(ws + WS_QM); bf16* KM = (bf16*)(ws + WS_KM); bf16* VTM = (bf16*)(ws + WS_VTM);
    bf16* OM = (bf16*)(ws + WS_OM); bf16* OS = SBQ; bf16* MERGED = (bf16*)(ws + WS_MERGED); float* TMP = (float*)(ws + WS_TMP); bf16* PB = (bf16*)(ws + WS_PB);
    bf16* GATES = (bf16*)P.out;

#ifdef PROBE_A
    unsigned long long* tsbuf = (unsigned long long*)(ws + 900 * 1024); int n_stamp = 0;
#define STAMP() do { if (blockIdx.x == 0 && wave_s == 0 && __builtin_amdgcn_mbcnt_hi(~0u, __builtin_amdgcn_mbcnt_lo(~0u, 0u)) == 0u) tsbuf[n_stamp] = __builtin_amdgcn_s_memrealtime(); ++n_stamp; } while (0)
#else
#define STAMP() do {} while (0)
#endif
    STAMP();
    float* RS0 = (float*)(ws + WS_RS); float* RS1 = RS0 + T; float* RS2 = RS0 + 2 * T; float* RS3 = RS0 + 3 * T; float* RSQ = RS0 + 4 * T; float* RSKV = RS0 + 5 * T;
    bf16* HB2 = (bf16*)(ws + WS_HB2); bf16* HHI = (bf16*)(ws + WS_H); bf16* HLO = (bf16*)(ws + WS_H + 64 * MiB);
    unsigned* barw = (unsigned*)(ws + 904 * 1024);
    volatile LAS unsigned* bst = (volatile LAS unsigned*)(lds + 135168);
    if (threadIdx.x < 2) bst[threadIdx.x] = 0u;
    __syncthreads();
    if (P.ws == nullptr) grid.sync();
    const XcdBarrier xbar = xcd_barrier_post(barw, bst, wave_s == 0 && __builtin_amdgcn_mbcnt_hi(~0u, __builtin_amdgcn_mbcnt_lo(~0u, 0u)) == 0u);
    { FRESH(); for (int i = gtid; i < 5 * T / 4; i += NT) ((f32x4*)RS1)[i] = (f32x4){0.f, 0.f, 0.f, 0.f}; }
    { FRESH(); prep_weights(P, lds, gw, NGW, wave, lane, 0, 1); }
    { FRESH(); x_phase(x, XN, RS0, gw, NGW, lane); }
    xcd_barrier(xbar, wave_s); STAMP();
    { Epi<M_SWIGLU> E{}; E.o0 = ACT; E.rs = RS0; E.rsn = 1.f / 1024.f; run_gemm<M_SWIGLU>(lds, XN, (const bf16*)(ws + WS_FF1IN), T, 2 * FF, DM, E, wave_s); }
    { FRESH(); prep_weights(P, lds, gw, NGW, wave, lane, 1, NJOBS_EARLY); }
    xcd_barrier(xbar, wave_s); STAMP();
    { Epi<M_RESID_FP> E{}; E.o0 = HHI; E.o1 = HLO; E.i0 = x; E.alpha = 0.5f; E.rso = RS1; run_gemm<M_RESID_FP>(lds, ACT, (const bf16*)(ws + WS_FF1OUT), T, DM, FF, E, wave_s); }
    xcd_barrier(xbar, wave_s); STAMP();
    { Epi<M_INPROJ> E{}; E.o0 = CQ; E.o1 = CKV; E.o2 = KR; E.o3 = SBQ; E.o4 = SBK; E.o5 = GATES; E.rs = RS1; E.rsn = 1.f / 1024.f; E.rso = RSQ; E.pos = (const int*)P.in[2]; E.g2 = P.in[13];
      run_gemm<M_INPROJ>(lds, HHI, (const bf16*)(ws + WS_WIN), T, 3840, DM, E, wave_s); }
    { Epi<M_VT> E{}; E.o0 = VTS; E.rs = RS1; E.rsn = 1.f / 1024.f; run_gemm<M_VT>(lds, (const bf16*)(ws + WS_WSBV), HHI, 512, T, DM, E, wave_s); }
    xcd_barrier(xbar, wave_s); STAMP();
    { Epi<M_QUP> E{}; E.o0 = QM; E.rs = RSQ; E.rsn = 1.f / 384.f; run_gemm<M_QUP>(lds, CQ, (const bf16*)(ws + WS_WQ), T, 768, 384, E, wave_s); }
    { Epi<M_KNOPE> E{}; E.o0 = KM; E.rs = RSKV; E.rsn = 1.f / 256.f; E.rs2 = RSKV + T; E.i0 = KR; E.g2 = P.in[13]; run_gemm<M_KNOPE>(lds, CKV, (const bf16*)(ws + WS_WKN), T, 512, 256, E, wave_s); }
    { Epi<M_VT> E{}; E.o0 = VTM; E.rs = RSKV; E.rsn = 1.f / 256.f; run_gemm<M_VT>(lds, (const bf16*)(ws + WS_WV), CKV, 512, T, 256, E, wave_s); }
    xcd_barrier(xbar, wave_s); STAMP();
    const int vcu = (G % 8 == 0) ? ((int)blockIdx.x % 8) * (G / 8) + (int)blockIdx.x / 8 : (int)blockIdx.x;
    { for (int pp = vcu; pp < 1024; pp += G) { FRESH(); const int c = pp & 255, k = pp >> 8, bh = c >> 2, s = c & 3;
        const int qb = k == 0 ? 15 - s : (k == 1 ? 8 + s : (k == 2 ? 7 - s : s));
        mla_unit(lds, QM, KM, VTM, OM, (const int*)P.in[2], P.in[12], P.in[13], bh, qb, tid, wave, lane); } }
    STAMP();
    { for (int uu = vcu; uu < 1024; uu += G) { FRESH(); sb_unit(lds, SBQ, SBK, VTS, OS, uu >> 4, uu & 15, tid, wave, lane); } }
    __syncthreads();
    { FRESH(); prep_weights(P, lds, gw, NGW, wave, lane, NJOBS_EARLY, NJOBS - 1); }
    { FRESH(); cvt_phase(P.in[1], PB, (size_t)T * 256 / 8, (size_t)gtid, (size_t)NT); }
    __syncthreads();
    xcd_barrier(xbar, wave_s); STAMP();
    { Epi<M_DUAL> E{}; E.o0 = MERGED; E.i0 = GATES; run_gemm_dual(lds, OM, (const bf16*)(ws + WS_WBM), OS, (const bf16*)(ws + WS_WBS), T, DM, 512, E, wave_s); }
    xcd_barrier(xbar, wave_s); STAMP();
    { Epi<M_RESID_PP> E{}; E.o0 = HB2; E.o1 = HLO; E.i0 = HHI; E.i1 = HLO; E.alpha = 1.0f; E.rso = RS2; run_gemm<M_RESID_PP>(lds, MERGED, (const bf16*)(ws + WS_WOUT), T, DM, DM, E, wave_s); }
    xcd_barrier(xbar, wave_s); STAMP();
    { Epi<M_SWIGLU> E{}; E.o0 = ACT; E.rs = RS2; E.rsn = 1.f / 1024.f; run_gemm<M_SWIGLU>(lds, HB2, (const bf16*)(ws + WS_FF2IN), T, 2 * FF, DM, E, wave_s); }
    xcd_barrier(xbar, wave_s); STAMP();
    { Epi<M_RESID_PP> E{}; E.o0 = XN; E.o1 = HLO; E.i0 = HB2; E.i1 = HLO; E.alpha = 0.5f; E.rso = RS3; run_gemm<M_RESID_PP>(lds, ACT, (const bf16*)(ws + WS_FF2OUT), T, DM, FF, E, wave_s); }
    xcd_barrier(xbar, wave_s); STAMP();
    { Epi<M_SIGM> E{}; E.o0 = TMP; E.rs = RS3; E.rsn = 1.f / 1024.f; run_gemm<M_SIGM>(lds, XN, (const bf16*)(ws + WS_WG), T, DM, DM, E, wave_s); }
    { Epi<M_FINAL> E{}; E.o0 = P.out; E.i0 = XN; E.o1 = HLO; E.i1 = TMP; run_gemm<M_FINAL>(lds, PB, (const bf16*)(ws + WS_WP), T, DM, 256, E, wave_s); }
#ifdef PROBE_A
    xcd_barrier(xbar, wave_s); STAMP();
    xcd_barrier(xbar, wave_s); STAMP();
    { const float pa = (float)(tsbuf[PROBE_B] - tsbuf[PROBE_A]) * 0.0001f, pb = (float)(tsbuf[PROBE_D] - tsbuf[PROBE_C]) * 0.000001f;
      FRESH();
      if (gtid == 0) P.out[0] += pa;
      for (int i = gtid; i < 4 * 1024 * 1024; i += NT) P.out[(size_t)4096 * 1024 + i] += pb; }
#endif
}

extern "C" void kernel_launch(void* const* d_in, const int* in_sizes, int n_in, void* d_out, int out_size, void* d_ws, size_t ws_size, hipStream_t stream) {
    static int grid = 0;
    if (grid == 0) {
        if (n_in != 23 || ws_size < WS_END) { fprintf(stderr, "kernel_launch: unexpected n_in %d / ws_size %zu\n", n_in, ws_size); grid = -1; return; }
        int dev = 0, cus = 0, per_cu = 0;
        hipGetDevice(&dev); hipDeviceGetAttribute(&cus, hipDeviceAttributeMultiprocessorCount, dev);
        if (hipFuncSetAttribute((const void*)mega_fwd, hipFuncAttributeMaxDynamicSharedMemorySize, LDS_BYTES) != hipSuccess) { fprintf(stderr, "hipFuncSetAttribute failed\n"); grid = -1; return; }
        if (hipOccupancyMaxActiveBlocksPerMultiprocessor(&per_cu, (const void*)mega_fwd, 512, LDS_BYTES) != hipSuccess || per_cu < 1) { fprintf(stderr, "occupancy query: %d\n", per_cu); per_cu = 1; }
        (void)hipGetLastError();
        grid = cus * per_cu;
    }
    if (grid < 0) return;
    Params p{};
    for (int i = 0; i < 23; ++i) p.in[i] = (const float*)d_in[i];
    p.out = (float*)d_out; p.ws = (unsigned char*)d_ws;
    if (hipMemsetAsync((char*)d_ws + 904 * 1024, 0, XCD_BAR_WORDS * sizeof(unsigned), stream) != hipSuccess) { fprintf(stderr, "kernel_launch: hipMemsetAsync of the barrier words failed\n"); return; }
    void* args[] = {&p};
    hipError_t e = hipLaunchCooperativeKernel((const void*)mega_fwd, dim3(grid), dim3(512), args, LDS_BYTES, stream);
    if (e != hipSuccess) fprintf(stderr, "cooperative launch failed: %s (grid %d)\n", hipGetErrorString(e), grid);
}
```
